# Optimizing an MI355X kernel written in HIP

```python
import math
import jax, jax.numpy as jnp
from jax import lax
import numpy as np

D_MODEL = 1024
BATCH = 32
SEQ = 2048
DEPTH = 2

HEAD_DIM = 64
MEM_LEN = 256
NORM_EPS = 1e-6
NEG = -1e30
SCALE = HEAD_DIM ** -0.5
A_HEADS = 4
A_CONFIGS = ((128, 1), (512, 4), (2048, 16))
B_HEADS = 4
SB_BLOCK = 128
C_HEADS = 4
C_KV_HEADS = 2
C_WINDOW = 128
D_HEADS = 4
MOBA_BLOCK = 256
MOBA_TOPK = 3
MOBA_QCHUNK = 16
BAND_BLOCK = 128
REL_BUCKETS = 32
REL_MAX_DIST = 2048
A_BIAS_LO = 0
C_BIAS_LO = A_HEADS
D_BIAS_LO = A_HEADS + C_HEADS
REL_HEADS = A_HEADS + C_HEADS + D_HEADS
X_HEADS = 4
X_HEAD_DIM = 64
X_W = X_HEADS * X_HEAD_DIM
X_SCALE = X_HEAD_DIM ** -0.5
D_FF = 4 * D_MODEL
A_W = A_HEADS * HEAD_DIM
B_W = B_HEADS * HEAD_DIM
C_QW = C_HEADS * HEAD_DIM
C_KVW = C_KV_HEADS * HEAD_DIM
D_W = D_HEADS * HEAD_DIM
IN_WIDTH = 3 * A_W + 3 * B_W + C_QW + 2 * C_KVW + 3 * D_W
MIX_WIDTH = A_W + B_W + C_QW + D_W

kernel_name = "hybrid_dilated_stickbreak_swa_moba_block"


def rmsnorm(x, g):
    xf = x.astype(jnp.float32)
    y = xf * lax.rsqrt(jnp.mean(xf * xf, axis=-1, keepdims=True) + NORM_EPS)
    return (y * g.astype(jnp.float32)).astype(x.dtype)


def rel_bucket(dist):
    max_exact = REL_BUCKETS // 2
    n = jnp.maximum(dist, 0)
    nf = jnp.maximum(n, 1).astype(jnp.float32)
    large = max_exact + (jnp.log(nf / max_exact) / math.log(REL_MAX_DIST / max_exact)
                         * (REL_BUCKETS - max_exact)).astype(jnp.int32)
    large = jnp.minimum(large, REL_BUCKETS - 1)
    return jnp.where(n < max_exact, n, large)


def rel_bias_heads(rel_table, dist, head_lo, n_heads):
    tab = rel_table[:, head_lo:head_lo + n_heads].astype(jnp.float32)
    return jnp.moveaxis(tab[rel_bucket(dist)], -1, 0)


def pad_to_multiple(x, axis, mult):
    n = x.shape[axis]
    pad = (-n) % mult
    if pad == 0:
        return x
    widths = [(0, 0)] * x.ndim
    widths[axis] = (0, pad)
    return jnp.pad(x, widths)


def to_blocks(x, blk):
    return x.reshape(x.shape[:-2] + (x.shape[-2] // blk, blk, x.shape[-1]))


def band_keys(xb):
    prev = jnp.concatenate([jnp.zeros_like(xb[..., :1, :, :]), xb[..., :-1, :, :]], axis=-3)
    return jnp.concatenate([prev, xb], axis=-2)


def band_geometry(n_blocks):
    qi = jnp.arange(BAND_BLOCK)[:, None]
    ki = jnp.arange(2 * BAND_BLOCK)[None, :]
    dist = qi + BAND_BLOCK - ki
    first_ok = (jnp.arange(n_blocks)[:, None, None] > 0) | (ki >= BAND_BLOCK)[None]
    return dist, first_ok


def dilated_attention(q, k, v, rel_table):
    B, H, S, E = q.shape
    blk = BAND_BLOCK
    nums, maxs, dens = [], [], []
    for window, dil in A_CONFIGS:
        span = window // dil
        L = S // dil

        def residue_blocks(t):
            t = t.reshape(B, H, L, dil, E).transpose(0, 1, 3, 2, 4)
            return to_blocks(pad_to_multiple(t, 3, blk), blk)

        qb = residue_blocks(q)
        kb = band_keys(residue_blocks(k))
        vb = band_keys(residue_blocks(v))
        nb = qb.shape[3]
        dist, first_ok = band_geometry(nb)
        valid = (dist >= 0) & (dist <= span) & first_ok
        bias = rel_bias_heads(rel_table, dist * dil, A_BIAS_LO, H)
        s = jnp.einsum("bhrnqe,bhrnke->bhrnqk", qb, kb) * SCALE + bias[None, :, None, None]
        s = jnp.where(valid, s, NEG)
        m = jnp.max(s, axis=-1)
        p = jnp.exp(s - m[..., None])
        l = jnp.sum(p, axis=-1)
        o = jnp.einsum("bhrnqk,bhrnke->bhrnqe", p, vb)

        def unres(t):
            t = t.reshape((B, H, dil, nb * blk) + t.shape[5:])[:, :, :, :L]
            t = jnp.swapaxes(t, 2, 3)
            return t.reshape((B, H, S) + t.shape[4:])

        nums.append(unres(o))
        maxs.append(unres(m))
        dens.append(unres(l))
    mx = jnp.stack(maxs)
    w = jnp.exp(mx - jnp.max(mx, axis=0, keepdims=True))
    num = jnp.einsum("cbhs,cbhse->bhse", w, jnp.stack(nums))
    den = jnp.sum(w * jnp.stack(dens), axis=0)
    return num / den[..., None]


def stick_breaking_attention(q, k, v):
    B, H, S, E = q.shape
    nblk = S // SB_BLOCK
    qs = q.reshape(B, H, nblk, SB_BLOCK, E).transpose(2, 0, 1, 3, 4)
    kpos = jnp.arange(S)

    def one_block(args):
        qb, i = args
        qpos = i * SB_BLOCK + jnp.arange(SB_BLOCK)
        z = jnp.einsum("bhqe,bhke->bhqk", qb, k) * SCALE
        past = kpos[None, :] < qpos[:, None]
        log_1m = jnp.where(past, jax.nn.log_sigmoid(-z), 0.0)
        suffix = lax.cumsum(log_1m, axis=3, reverse=True) - log_1m
        a = jnp.where(past, jnp.exp(jax.nn.log_sigmoid(z) + suffix), 0.0)
        return jnp.einsum("bhqk,bhke->bhqe", a, v)

    out = lax.map(one_block, (qs, jnp.arange(nblk)))
    return out.transpose(1, 2, 0, 3, 4).reshape(B, H, S, E)


def sliding_window_sink_attention(q, k, v, sinks, rel_table):
    B, Hq, S, E = q.shape
    G = k.shape[1]
    R = Hq // G
    blk = BAND_BLOCK
    qb = to_blocks(q.reshape(B, G, R, S, E), blk)
    kb = band_keys(to_blocks(k, blk))
    vb = band_keys(to_blocks(v, blk))
    nb = qb.shape[3]
    dist, first_ok = band_geometry(nb)
    valid = (dist >= 0) & (dist < C_WINDOW) & first_ok
    bias = rel_bias_heads(rel_table, dist, C_BIAS_LO, Hq).reshape(G, R, blk, 2 * blk)
    s = jnp.einsum("bgrnqe,bgnke->bgrnqk", qb, kb) * SCALE + bias[None, :, :, None]
    s = jnp.where(valid, s, NEG)
    sink = sinks.astype(jnp.float32).reshape(G, R)[None, :, :, None, None, None]
    m = jnp.maximum(jnp.max(s, axis=-1, keepdims=True), sink)
    p = jnp.exp(s - m)
    den = jnp.sum(p, axis=-1, keepdims=True) + jnp.exp(sink - m)
    o = jnp.einsum("bgrnqk,bgnke->bgrnqe", p / den, vb)
    return o.reshape(B, Hq, S, E)


def moba_attention(q, k, v, rel_table):
    B, H, S, E = q.shape
    blk = MOBA_BLOCK
    qp = pad_to_multiple(q, 2, blk)
    kp = pad_to_multiple(k, 2, blk)
    vp = pad_to_multiple(v, 2, blk)
    Sp = qp.shape[2]
    nblk = Sp // blk
    kblk = kp.reshape(B, H, nblk, blk, E)
    vblk = vp.reshape(B, H, nblk, blk, E)
    kmean = jnp.mean(kblk, axis=3)
    qblock = jnp.arange(Sp) // blk
    fully_past = jnp.arange(nblk)[None, :] < qblock[:, None]
    gate = jnp.where(fully_past, jnp.einsum("bhse,bhne->bhsn", qp, kmean), NEG)
    n_sel = min(MOBA_TOPK, nblk)
    _, sel = lax.top_k(gate, n_sel)
    sel_ok = sel < qblock[:, None]
    tab = rel_table[:, D_BIAS_LO:D_BIAS_LO + H].T.astype(jnp.float32)
    b_ix = jnp.arange(B)[:, None, None, None]
    h_ix = jnp.arange(H)[None, :, None, None]
    offs = jnp.arange(blk)

    def one_chunk(c):
        start = c * MOBA_QCHUNK
        qc = lax.dynamic_slice_in_dim(qp, start, MOBA_QCHUNK, axis=2)
        idx = lax.dynamic_slice_in_dim(sel, start, MOBA_QCHUNK, axis=2)
        ok = lax.dynamic_slice_in_dim(sel_ok, start, MOBA_QCHUNK, axis=2)
        tpos = start + jnp.arange(MOBA_QCHUNK)
        own = start // blk
        k_own = lax.dynamic_index_in_dim(kblk, own, axis=2, keepdims=False)
        v_own = lax.dynamic_index_in_dim(vblk, own, axis=2, keepdims=False)
        d_own = tpos[:, None] - (own * blk + offs)[None, :]
        s_own = jnp.einsum("bhqe,bhke->bhqk", qc, k_own) * SCALE + tab[:, rel_bucket(d_own)][None]
        s_own = jnp.where(d_own >= 0, s_own, NEG)
        k_sel = kblk[b_ix, h_ix, idx]
        v_sel = vblk[b_ix, h_ix, idx]
        d_sel = tpos[:, None, None] - (idx[..., None] * blk + offs)
        s_sel = (jnp.einsum("bhqe,bhqjke->bhqjk", qc, k_sel) * SCALE
                 + tab[h_ix[..., None], rel_bucket(d_sel)])
        s_sel = jnp.where(ok[..., None], s_sel, NEG).reshape(B, H, MOBA_QCHUNK, n_sel * blk)
        p = jax.nn.softmax(jnp.concatenate([s_own, s_sel], axis=-1), axis=-1)
        p_own = p[..., :blk]
        p_sel = p[..., blk:].reshape(B, H, MOBA_QCHUNK, n_sel, blk)
        return (jnp.einsum("bhqk,bhke->bhqe", p_own, v_own)
                + jnp.einsum("bhqjk,bhqjke->bhqe", p_sel, v_sel))

    out = lax.map(one_chunk, jnp.arange(Sp // MOBA_QCHUNK))
    return out.transpose(1, 2, 0, 3, 4).reshape(B, H, Sp, E)[:, :, :S]


def hybrid_mixer(h, w_in, g_group, sinks, w_out, rel_table):
    B, S, _ = h.shape
    proj = (h @ w_in).astype(jnp.float32)
    sizes = (A_W, A_W, A_W, B_W, B_W, B_W, C_QW, C_KVW, C_KVW, D_W, D_W, D_W)
    cuts = []
    acc = 0
    for sz in sizes[:-1]:
        acc += sz
        cuts.append(acc)
    aq, ak, av, bq, bk, bv, cq, ck, cv, dq, dk, dv = jnp.split(proj, cuts, axis=-1)

    def heads(t):
        return t.reshape(B, S, -1, HEAD_DIM).transpose(0, 2, 1, 3)

    ya = dilated_attention(heads(aq), heads(ak), heads(av), rel_table)
    yb = stick_breaking_attention(heads(bq), heads(bk), heads(bv))
    yc = sliding_window_sink_attention(heads(cq), heads(ck), heads(cv), sinks, rel_table)
    yd = moba_attention(heads(dq), heads(dk), heads(dv), rel_table)
    groups = []
    for y in (ya, yb, yc, yd):
        y = y.transpose(0, 2, 1, 3).reshape(B, S, -1)
        groups.append(y * lax.rsqrt(jnp.mean(y * y, axis=-1, keepdims=True) + NORM_EPS))
    y = jnp.concatenate(groups, axis=-1) * g_group.astype(jnp.float32)
    return y.astype(h.dtype) @ w_out


def memory_cross_attention(h, m, w_q, w_kv, w_o):
    B, S, _ = h.shape
    M = m.shape[1]
    q = (h @ w_q).astype(jnp.float32).reshape(B, S, X_HEADS, X_HEAD_DIM)
    kv = (m @ w_kv).astype(jnp.float32)
    k = kv[..., :X_W].reshape(B, M, X_HEADS, X_HEAD_DIM)
    v = kv[..., X_W:].reshape(B, M, X_HEADS, X_HEAD_DIM)
    p = jax.nn.softmax(jnp.einsum("bshe,bmhe->bhsm", q, k) * X_SCALE, axis=-1)
    o = jnp.einsum("bhsm,bmhe->bshe", p, v).reshape(B, S, X_W)
    return o.astype(h.dtype) @ w_o


def squared_relu_mlp(h, w_up, w_down):
    return jnp.square(jax.nn.relu(h @ w_up)) @ w_down


def setup_inputs(seed: int = 0) -> dict:
    key = jax.random.key(seed)
    ks = jax.random.split(key, 17)
    f32 = jnp.float32

    def nrm(k, shape, scale):
        return jax.random.normal(k, shape, f32) * scale

    def gain(k, shape):
        return 1.0 + 0.02 * jax.random.normal(k, shape, f32)

    return {
        "x": nrm(ks[0], (BATCH, SEQ, D_MODEL), 1.0),
        "mem": nrm(ks[1], (BATCH, MEM_LEN, D_MODEL), 1.0),
        "rel_table": nrm(ks[2], (REL_BUCKETS, REL_HEADS), 0.5),
        "g_mix": gain(ks[3], (DEPTH, D_MODEL)),
        "w_in": nrm(ks[4], (DEPTH, D_MODEL, IN_WIDTH), D_MODEL ** -0.5),
        "g_group": gain(ks[5], (DEPTH, MIX_WIDTH)),
        "sinks": nrm(ks[6], (DEPTH, C_HEADS), 0.5),
        "w_out": nrm(ks[7], (DEPTH, MIX_WIDTH, D_MODEL), MIX_WIDTH ** -0.5),
        "g_cross": gain(ks[8], (DEPTH, D_MODEL)),
        "g_mem": gain(ks[9], (DEPTH, D_MODEL)),
        "w_xq": nrm(ks[10], (DEPTH, D_MODEL, X_W), D_MODEL ** -0.5),
        "w_xkv": nrm(ks[11], (DEPTH, D_MODEL, 2 * X_W), D_MODEL ** -0.5),
        "w_xo": nrm(ks[12], (DEPTH, X_W, D_MODEL), X_W ** -0.5),
        "g_mlp": gain(ks[13], (DEPTH, D_MODEL)),
        "w_up": nrm(ks[14], (DEPTH, D_MODEL, D_FF), D_MODEL ** -0.5),
        "w_down": nrm(ks[15], (DEPTH, D_FF, D_MODEL), D_FF ** -0.5),
        "g_final": gain(ks[16], (D_MODEL,)),
    }


def reference(x, mem, rel_table, g_mix, w_in, g_group, sinks, w_out, g_cross, g_mem,
              w_xq, w_xkv, w_xo, g_mlp, w_up, w_down, g_final):
    for l in range(DEPTH):
        x = x + hybrid_mixer(rmsnorm(x, g_mix[l]), w_in[l], g_group[l], sinks[l], w_out[l], rel_table)
        x = x + memory_cross_attention(rmsnorm(x, g_cross[l]), rmsnorm(mem, g_mem[l]),
                                       w_xq[l], w_xkv[l], w_xo[l])
        x = x + squared_relu_mlp(rmsnorm(x, g_mlp[l]), w_up[l], w_down[l])
    return rmsnorm(x, g_final)
```

```cpp
#include <hip/hip_runtime.h>
#include <cstdio>
#include <cstdint>
namespace pg8 {
#define PG8_LAS __attribute__((address_space(3)))
typedef unsigned short bf16_t;
typedef short bf16x8 __attribute__((ext_vector_type(8)));
typedef float f32x4 __attribute__((ext_vector_type(4)));
typedef unsigned u32x4 __attribute__((ext_vector_type(4)));
constexpr int BM = 256, BK = 64, HALF = 128, HTB = HALF * BK * 2  , STAGE_BYTES = 8 * HTB, NXCD = 8, WGM = 8;

__host__ __device__ __forceinline__ int lds_byte(int r, int c) { const int st = (r >> 4) * 2 + (c >> 5), rr = r & 15, cc = c & 31, ob = rr * 64 + cc * 2; return st * 1024 + (ob ^ (((ob >> 9) & 1) << 5)); }
__host__ __device__ __forceinline__ void stage_rc(int b, int& R, int& C) { const int st = b / 1024, sb = b % 1024, swz = sb ^ (((sb >> 9) & 1) << 5); R = (st >> 1) * 16 + swz / 64; C = (st & 1) * 32 + (swz % 64) / 2; }
__host__ __device__ __forceinline__ int perm32(int rho) { const int n = rho >> 4, i = rho & 15; return 8 * (i >> 2) + 4 * n + (i & 3); }

struct Unit { int pm, pn; };
struct Gemm { const bf16_t* A; const bf16_t* Bt; int M, N, K; };

struct StaticOrder {
    int nM, nN, nwg, G, c;
    __host__ __device__ void init(int M, int N, int G_, int c_) { nM = M / BM; nN = N / BM; nwg = nM * nN; G = G_; c = c_; }
    __host__ __device__ bool next(int i, Unit& u) const {
        const long L = (long)i * G + c; if (L >= nwg) return false;
        int wgid = (int)L; { const int q = nwg / NXCD, r = nwg % NXCD, xcd = wgid % NXCD, off = wgid / NXCD; wgid = (xcd < r ? xcd * (q + 1) : r * (q + 1) + (xcd - r) * q) + off; }
        const int nig = WGM * nN, gid = wgid / nig, fm = gid * WGM, gsz = (nM - fm) < WGM ? (nM - fm) : WGM;
        u.pm = fm + ((wgid % nig) % gsz); u.pn = (wgid % nig) / gsz; return true;
    }
    __device__ __forceinline__ void a_ready(const Unit&) const {}
    __device__ __forceinline__ void done(const Unit&) const {}
};

__device__ __forceinline__ unsigned cvt_pk_bf16(float lo, float hi) { unsigned r; asm volatile("v_cvt_pk_bf16_f32 %0, %1, %2" : "=v"(r) : "v"(lo), "v"(hi)); return r; }
typedef float f32x2 __attribute__((ext_vector_type(2)));
constexpr float RMS_EPS = 1e-6f;
__device__ __forceinline__ float row_rs(const float* ssq, int row) {
    const f32x4* p = (const f32x4*)(ssq + (size_t)row * 16);
    const f32x4 a = p[0], b = p[1], c = p[2], d = p[3];
    const float s = (((a[0] + a[1]) + (a[2] + a[3])) + ((b[0] + b[1]) + (b[2] + b[3]))) + (((c[0] + c[1]) + (c[2] + c[3])) + ((d[0] + d[1]) + (d[2] + d[3])));
    return __builtin_amdgcn_rsqf(s * (1.0f / 1024.0f) + RMS_EPS);
}
template <int ACT> struct EpiRowScale {
    static constexpr bool PERM = true, AFTER_DRAIN = false;
    bf16_t* O; int ldc; const float* ssq;
    __device__ __forceinline__ void operator()(const f32x4 (&acc)[2][2][4][2], const Unit& u, int wr, int wc, int fr, int fq) const {
        const int row0 = u.pm * BM + wr * 64 + fr, col0 = u.pn * BM + wc * 32 + 8 * fq;
#pragma unroll
        for (int ai = 0; ai < 2; ++ai)
#pragma unroll
            for (int m = 0; m < 4; ++m) {
                const int row = row0 + ai * HALF + m * 16;
                const float rs = ssq ? row_rs(ssq, row) : 1.0f;
                bf16_t* rowp = O + (size_t)row * ldc + col0;
#pragma unroll
                for (int bj = 0; bj < 2; ++bj) {
                    f32x4 v0 = acc[ai][bj][m][0] * rs, v1 = acc[ai][bj][m][1] * rs;
                    if (ACT == 1) {
#pragma unroll
                        for (int e = 0; e < 4; ++e) { const float a = __builtin_fmaxf(v0[e], 0.f), b = __builtin_fmaxf(v1[e], 0.f); v0[e] = a * a; v1[e] = b * b; }
                    }
                    u32x4 w; w.x = cvt_pk_bf16(v0[0], v0[1]); w.y = cvt_pk_bf16(v0[2], v0[3]); w.z = cvt_pk_bf16(v1[0], v1[1]); w.w = cvt_pk_bf16(v1[2], v1[3]);
                    *(u32x4*)(rowp + bj * HALF) = w;
                }
                if (m & 1) asm volatile("" ::: "memory");
            }
    }
};
struct EpiResid {
    static constexpr bool PERM = true, AFTER_DRAIN = false;
    const float* base; float* out; bf16_t* xb; float* ssq;
    __device__ __forceinline__ void operator()(const f32x4 (&acc)[2][2][4][2], const Unit& u, int wr, int wc, int fr, int fq) const {
        const int row0 = u.pm * BM + wr * 64 + fr, col0 = u.pn * BM + wc * 32 + 8 * fq, slot = u.pn * 4 + wc;
#pragma unroll
        for (int ai = 0; ai < 2; ++ai)
#pragma unroll
            for (int m = 0; m < 4; ++m) {
                const int row = row0 + ai * HALF + m * 16;
                const size_t off = (size_t)row * 1024 + col0;
                float ss = 0.f;
#pragma unroll
                for (int bj = 0; bj < 2; ++bj) {
                    const f32x4 b0 = *(const f32x4*)(base + off + bj * HALF), b1 = *(const f32x4*)(base + off + bj * HALF + 4);
                    const f32x4 v0 = acc[ai][bj][m][0] + b0, v1 = acc[ai][bj][m][1] + b1;
                    *(f32x4*)(out + off + bj * HALF) = v0; *(f32x4*)(out + off + bj * HALF + 4) = v1;
                    ss += ((v0[0] * v0[0] + v0[1] * v0[1]) + (v0[2] * v0[2] + v0[3] * v0[3])) + ((v1[0] * v1[0] + v1[1] * v1[1]) + (v1[2] * v1[2] + v1[3] * v1[3]));
                    u32x4 w; w.x = cvt_pk_bf16(v0[0], v0[1]); w.y = cvt_pk_bf16(v0[2], v0[3]); w.z = cvt_pk_bf16(v1[0], v1[1]); w.w = cvt_pk_bf16(v1[2], v1[3]);
                    *(u32x4*)(xb + off + bj * HALF) = w;
                }
                ss += __shfl_xor(ss, 16); ss += __shfl_xor(ss, 32);
                if (fq == 0) ssq[(size_t)row * 16 + slot] = ss;
                asm volatile("" ::: "memory");
            }
    }
};

template <class Epi, class Sched, bool ALIGN_EPI = false, bool SP2 = false>
__device__ __forceinline__ void gemm_phase(PG8_LAS unsigned char* lds, const Gemm g, const Sched& S, const Epi& E) {
    const int tid = threadIdx.x, wid = __builtin_amdgcn_readfirstlane(tid >> 6), lane = tid & 63, wr = wid >> 2, wc = wid & 3, fr = lane & 15, fq = lane >> 4;
    const int K = g.K, nt = K / BK;
    unsigned voffA[2], voffB[2];
#pragma unroll
    for (int i = 0; i < 2; ++i) { int R, C; stage_rc(tid * 16 + i * 8192, R, C); const int Rb = Epi::PERM ? ((R & ~31) + perm32(R & 31)) : R;
        voffA[i] = (unsigned)(R * K + C) * 2u; voffB[i] = (unsigned)(Rb * K + C) * 2u; }
    const size_t kstep = (size_t)(BK * 2);
    const size_t hstep = (size_t)HALF * K * 2;
    const size_t tstep = 2 * hstep;
    const unsigned ldsw = (unsigned)wid * 1024u;
    const int aoff = lds_byte(wr * 64 + fr, fq * 8), boff = lds_byte(wc * 32 + fr, fq * 8);
#define PG8_SA(b, h) (((b) * 2 + (h)) * HTB)
#define PG8_SB(b, h) ((4 + (b) * 2 + (h)) * HTB)
#define PG8_STAGE(bufoff, gbase, voff) do { _Pragma("unroll") for (int _i = 0; _i < 2; ++_i) \
        __builtin_amdgcn_global_load_lds((const unsigned*)((const char*)(gbase) + (voff)[_i]), (PG8_LAS unsigned*)(lds + (bufoff) + ldsw + _i * 8192), 16, 0, 0); } while (0)
#define PG8_LDA(dst, b, h) do { _Pragma("unroll") for (int m = 0; m < 4; ++m) _Pragma("unroll") for (int k = 0; k < 2; ++k) dst[m][k] = *(const PG8_LAS bf16x8*)(lds + PG8_SA(b, h) + aoff + m * 2048 + k * 1024); } while (0)
#define PG8_LDB(dst, b, h) do { _Pragma("unroll") for (int n = 0; n < 2; ++n) _Pragma("unroll") for (int k = 0; k < 2; ++k) dst[n][k] = *(const PG8_LAS bf16x8*)(lds + PG8_SB(b, h) + boff + n * 2048 + k * 1024); } while (0)
#define PG8_MMA(ai, bj, At, Bt) do { __builtin_amdgcn_s_setprio(1); _Pragma("unroll") for (int m = 0; m < 4; ++m) _Pragma("unroll") for (int n = 0; n < 2; ++n) _Pragma("unroll") for (int k = 0; k < 2; ++k) \
        acc[ai][bj][m][n] = __builtin_amdgcn_mfma_f32_16x16x32_bf16(Bt[n][k], At[m][k], acc[ai][bj][m][n], 0, 0, 0); __builtin_amdgcn_s_setprio(0); } while (0)
#define PG8_WAIT_V(n) asm volatile("s_waitcnt vmcnt(" #n ")" ::: "memory")
#define PG8_WAIT_L(n) asm volatile("s_waitcnt lgkmcnt(" #n ")" ::: "memory")
#define PG8_BAR __builtin_amdgcn_s_barrier()
#define PG8_SCHED __builtin_amdgcn_sched_barrier(0)
    Unit cur, nxt; int ui = 0;
    if (!S.next(0, cur)) return;
    f32x4 acc[2][2][4][2];
#pragma unroll
    for (int a = 0; a < 2; ++a)
#pragma unroll
        for (int b = 0; b < 2; ++b)
#pragma unroll
            for (int m = 0; m < 4; ++m)
#pragma unroll
                for (int n = 0; n < 2; ++n) acc[a][b][m][n] = (f32x4){0.f, 0.f, 0.f, 0.f};
    bf16x8 At[4][2], B0[2][2], B1[2][2];
    const char* cA = (const char*)g.A + (size_t)cur.pm * tstep; const char* cB = (const char*)g.Bt + (size_t)cur.pn * tstep;
    S.a_ready(cur);
    if constexpr (SP2) {
        PG8_STAGE(PG8_SB(0, 0), cB, voffB); PG8_STAGE(PG8_SB(0, 1), cB + hstep, voffB); PG8_STAGE(PG8_SA(0, 0), cA, voffA); PG8_STAGE(PG8_SA(0, 1), cA + hstep, voffA);
        if (wr == 1) PG8_BAR;
        PG8_WAIT_V(2); PG8_BAR;
        PG8_STAGE(PG8_SB(1, 0), cB + kstep, voffB); PG8_STAGE(PG8_SA(1, 0), cA + kstep, voffA); PG8_STAGE(PG8_SB(1, 1), cB + hstep + kstep, voffB);
        PG8_WAIT_V(6); PG8_BAR;
    } else {
        PG8_STAGE(PG8_SB(0, 0), cB, voffB); PG8_STAGE(PG8_SA(0, 0), cA, voffA); PG8_STAGE(PG8_SB(0, 1), cB + hstep, voffB); PG8_STAGE(PG8_SA(0, 1), cA + hstep, voffA);
        if (wr == 1) PG8_BAR;
        PG8_WAIT_V(4); PG8_BAR;
        PG8_STAGE(PG8_SB(1, 0), cB + kstep, voffB); PG8_STAGE(PG8_SA(1, 0), cA + kstep, voffA); PG8_STAGE(PG8_SB(1, 1), cB + hstep + kstep, voffB);
        PG8_WAIT_V(6); PG8_BAR;
    }
    for (;;) {
        const bool has_next = S.next(ui + 1, nxt);
        const char* nA = has_next ? (const char*)g.A + (size_t)nxt.pm * tstep : cA; const char* nB = has_next ? (const char*)g.Bt + (size_t)nxt.pn * tstep : cB;
        for (int t = 0; t < nt; t += 2) {
            const bool last = (t == nt - 2);
            const char* a1 = cA + (size_t)(t + 1) * kstep;
            const char* a2 = last ? nA : cA + (size_t)(t + 2) * kstep; const char* b2 = last ? nB : cB + (size_t)(t + 2) * kstep;
            const char* a3 = a2 + kstep; const char* b3 = b2 + kstep;
            if (last && has_next) S.a_ready(nxt);
            if constexpr (SP2) {
            PG8_LDB(B0, 0, 0); PG8_LDB(B1, 0, 1); PG8_SCHED; PG8_LDA(At, 0, 0); PG8_STAGE(PG8_SA(1, 1), a1 + hstep, voffA);
            PG8_WAIT_V(8); PG8_WAIT_L(0); PG8_BAR; PG8_MMA(0, 0, At, B0); PG8_MMA(0, 1, At, B1); PG8_BAR; PG8_SCHED;
            PG8_LDA(At, 0, 1); PG8_STAGE(PG8_SB(0, 0), b2, voffB); PG8_STAGE(PG8_SB(0, 1), b2 + hstep, voffB); PG8_STAGE(PG8_SA(0, 0), a2, voffA);
            PG8_WAIT_V(8); PG8_WAIT_L(0); PG8_BAR; PG8_MMA(1, 0, At, B0); PG8_MMA(1, 1, At, B1); PG8_BAR; PG8_SCHED;
            PG8_LDB(B0, 1, 0); PG8_LDB(B1, 1, 1); PG8_SCHED; PG8_LDA(At, 1, 0); PG8_STAGE(PG8_SA(0, 1), a2 + hstep, voffA);
            PG8_WAIT_V(8); PG8_WAIT_L(0); PG8_BAR; PG8_MMA(0, 0, At, B0); PG8_MMA(0, 1, At, B1); PG8_BAR; PG8_SCHED;
            PG8_LDA(At, 1, 1); PG8_STAGE(PG8_SB(1, 0), b3, voffB); PG8_STAGE(PG8_SB(1, 1), b3 + hstep, voffB); PG8_STAGE(PG8_SA(1, 0), a3, voffA);
            PG8_WAIT_V(8); PG8_WAIT_L(0); PG8_BAR; PG8_MMA(1, 0, At, B0); PG8_MMA(1, 1, At, B1); PG8_BAR; PG8_SCHED;
            } else {
            PG8_LDB(B0, 0, 0); PG8_SCHED; PG8_LDA(At, 0, 0); PG8_STAGE(PG8_SA(1, 1), a1 + hstep, voffA);
            PG8_WAIT_L(8); PG8_BAR; PG8_WAIT_L(0); PG8_MMA(0, 0, At, B0); PG8_BAR; PG8_SCHED;
            PG8_LDB(B1, 0, 1); PG8_STAGE(PG8_SB(0, 0), b2, voffB);
            PG8_BAR; PG8_WAIT_L(0); PG8_MMA(0, 1, At, B1); PG8_BAR;
            PG8_LDA(At, 0, 1); PG8_STAGE(PG8_SA(0, 0), a2, voffA);
            PG8_BAR; PG8_WAIT_L(0); PG8_MMA(1, 0, At, B0); PG8_BAR; PG8_SCHED;
            PG8_STAGE(PG8_SB(0, 1), b2 + hstep, voffB);
            PG8_WAIT_V(6); PG8_BAR; PG8_MMA(1, 1, At, B1); PG8_BAR;
            PG8_LDB(B0, 1, 0); PG8_SCHED; PG8_LDA(At, 1, 0); PG8_STAGE(PG8_SA(0, 1), a2 + hstep, voffA);
            PG8_WAIT_L(8); PG8_BAR; PG8_WAIT_L(0); PG8_MMA(0, 0, At, B0); PG8_BAR; PG8_SCHED;
            PG8_LDB(B1, 1, 1); PG8_STAGE(PG8_SB(1, 0), b3, voffB);
            PG8_BAR; PG8_WAIT_L(0); PG8_MMA(0, 1, At, B1); PG8_BAR;
            PG8_LDA(At, 1, 1); PG8_STAGE(PG8_SA(1, 0), a3, voffA);
            PG8_BAR; PG8_WAIT_L(0); PG8_MMA(1, 0, At, B0); PG8_BAR; PG8_SCHED;
            PG8_STAGE(PG8_SB(1, 1), b3 + hstep, voffB);
            PG8_WAIT_V(6); PG8_BAR; PG8_MMA(1, 1, At, B1); PG8_BAR;
            }
        }
        if constexpr (ALIGN_EPI) { if (wr == 0) PG8_BAR; }
        if constexpr (!Epi::AFTER_DRAIN) { E(acc, cur, wr, wc, fr, fq); S.done(cur); }
        if (!has_next) break;
#pragma unroll
        for (int a = 0; a < 2; ++a)
#pragma unroll
            for (int b = 0; b < 2; ++b)
#pragma unroll
                for (int m = 0; m < 4; ++m)
#pragma unroll
                    for (int n = 0; n < 2; ++n) acc[a][b][m][n] = (f32x4){0.f, 0.f, 0.f, 0.f};
        cur = nxt; cA = nA; cB = nB; ++ui;
        if constexpr (ALIGN_EPI) { if (wr == 1) PG8_BAR; }
    }
    PG8_WAIT_V(0);
    if constexpr (!ALIGN_EPI) { if (wr == 0) PG8_BAR; }
    PG8_BAR;
    if constexpr (Epi::AFTER_DRAIN) { E.fused(acc, cur, wr, wc, fr, fq, lds, wid, lane); S.done(cur); }
#undef PG8_SA
#undef PG8_SB
#undef PG8_STAGE
#undef PG8_LDA
#undef PG8_LDB
#undef PG8_MMA
#undef PG8_WAIT_V
#undef PG8_WAIT_L
#undef PG8_BAR
#undef PG8_SCHED
}
}
#define GAS __attribute__((address_space(1)))
#define LAS __attribute__((address_space(3)))
typedef unsigned short bf16;
typedef unsigned v4u __attribute__((ext_vector_type(4)));
typedef float f32x4 __attribute__((ext_vector_type(4)));
typedef short bf16x8 __attribute__((ext_vector_type(8)));
typedef GAS unsigned gu32;
typedef GAS unsigned long long gu64;
#define RLX_AGENT __ATOMIC_RELAXED, __HIP_MEMORY_SCOPE_AGENT
#define LDS_WAIT() asm volatile("s_waitcnt lgkmcnt(0)" ::: "memory")
#define VM_WAIT() asm volatile("s_waitcnt vmcnt(0)" ::: "memory")
__device__ __forceinline__ unsigned long long rt() { return __builtin_amdgcn_s_memrealtime(); }
__device__ __forceinline__ unsigned f2bf(float f) { unsigned u = __builtin_bit_cast(unsigned, f); return (u + 0x7fffu + ((u >> 16) & 1u)) >> 16; }
__device__ __forceinline__ unsigned pk2(float lo, float hi) { return f2bf(lo) | (f2bf(hi) << 16); }
#define XB_TMO      128
#define XB_XCNT(j)  (256  + 64 * (j))
#define XB_XSUB(j)  (1280 + 64 * (j))
#define XB_XGEN(j)  (2304 + 64 * (j))
#define XB_TOP      3328
#define XB_TOPGEN   3392
#define XCD_BAR_WORDS 3456
#define XB_SPIN_CAP (1u << 18)

__device__ __forceinline__ unsigned xb_ld(unsigned* p)              { return __hip_atomic_load(p, __ATOMIC_RELAXED, __HIP_MEMORY_SCOPE_AGENT); }
__device__ __forceinline__ unsigned xb_add(unsigned* p, unsigned v) { return __hip_atomic_fetch_add(p, v, __ATOMIC_RELAXED, __HIP_MEMORY_SCOPE_AGENT); }
__device__ __forceinline__ unsigned xb_xcc_id() { return (unsigned)__builtin_amdgcn_s_getreg((3 << 11) | 20) & 0xFu; }
#define XB_SPIN(cond, bar) do { unsigned _sp = 0; while (cond) { __builtin_amdgcn_s_sleep(1); \
    if ((++_sp & 255u) == 0u) { if (xb_ld(&(bar)[XB_TMO])) break; if (_sp > XB_SPIN_CAP) { atomicAdd(&(bar)[XB_TMO], 1u); break; } } } } while (0)

struct XcdBarrier {
    unsigned* bar; unsigned x;
    volatile LAS unsigned* st;
};

__device__ __forceinline__ XcdBarrier xcd_barrier_post(unsigned* bar, volatile LAS unsigned* st) {
    XcdBarrier b; b.bar = bar; b.x = xb_xcc_id(); b.st = st;
    if (threadIdx.x == 0) (void)xb_add(&bar[XB_XCNT(b.x)], 1u);
    return b;
}
__device__ __forceinline__ void xcd_barrier_complete(unsigned* bar, unsigned x, unsigned& nloc, unsigned& nx) {
    const unsigned G = gridDim.x * gridDim.y * gridDim.z;
    unsigned sum, cnt, mine, sp = 0u;
    for (;;) {
        sum = 0u; cnt = 0u; mine = 0u;
#pragma unroll
        for (unsigned j = 0; j < 16; ++j) { const unsigned c = xb_ld(&bar[XB_XCNT(j)]); sum += c; cnt += (c > 0u) ? 1u : 0u; mine = (j == x) ? c : mine; }
        if (sum == G) break;
        __builtin_amdgcn_s_sleep(1);
        if ((++sp & 255u) == 0u) { if (xb_ld(&bar[XB_TMO])) break; if (sp > XB_SPIN_CAP) { atomicAdd(&bar[XB_TMO], 1u); break; } }
    }
    nloc = mine > 0u ? mine : 1u; nx = cnt > 0u ? cnt : 1u;
}

__device__ __forceinline__ void xcd_barrier(const XcdBarrier& b) {
    asm volatile("s_waitcnt vmcnt(0)" ::: "memory");
    __syncthreads();
    if (threadIdx.x == 0) {
        unsigned* bar = b.bar;
        __builtin_amdgcn_s_waitcnt(0);
        unsigned nloc = b.st[0], nx = b.st[1];
        if (nloc == 0u) { xcd_barrier_complete(bar, b.x, nloc, nx); b.st[0] = nloc; b.st[1] = nx; }
        const unsigned old = xb_add(&bar[XB_XSUB(b.x)], 1u);
        const unsigned gen = old / nloc;
        if (old + 1u == (gen + 1u) * nloc) {
            __builtin_amdgcn_fence(__ATOMIC_RELEASE, "agent");
            asm volatile("s_waitcnt vmcnt(0)" ::: "memory");
            const unsigned og = xb_add(&bar[XB_TOP], 1u);
            const unsigned tg = og / nx;
            if (og + 1u == (tg + 1u) * nx) xb_add(&bar[XB_TOPGEN], 1u);
            else XB_SPIN(xb_ld(&bar[XB_TOPGEN]) == tg, bar);
            __builtin_amdgcn_fence(__ATOMIC_ACQUIRE, "agent");
            xb_add(&bar[XB_XGEN(b.x)], 1u);
            asm volatile("s_waitcnt vmcnt(0)" ::: "memory");
        } else {
            XB_SPIN(xb_ld(&bar[XB_XGEN(b.x)]) == gen, bar);
            __builtin_amdgcn_fence(__ATOMIC_ACQUIRE, "agent");
            asm volatile("s_waitcnt vmcnt(0)" ::: "memory");
        }
    }
    __syncthreads();
}
constexpr int NWAVES = 8;
constexpr int BATCH = 32, SEQ = 2048, D = 1024, M = BATCH * SEQ, INW = 2816, FF = 4096, MEMLEN = 256, MROWS = BATCH * MEMLEN, XW = 256, DEPTH = 2;
constexpr float NORM_EPS = 1e-6f;
constexpr float LOG2E = 1.4426950408889634f;
constexpr float C2 = 0.125f * LOG2E;
constexpr int COL_AQ = 0, COL_AK = 256, COL_AV = 512, COL_BQ = 768, COL_BK = 1024, COL_BV = 1280, COL_CQ = 1536, COL_CK = 1792, COL_CV = 1920, COL_DQ = 2048, COL_DK = 2304, COL_DV = 2560;
constexpr int BT_STRIDE = 2112;

constexpr size_t MiB = 1u << 20;
constexpr size_t WS_CTL = 0, CTL_ZERO_BYTES = 1 * MiB;
constexpr size_t WS_BT = 1 * MiB;
constexpr size_t WS_KMEAN = 1 * MiB + 512 * 1024;
constexpr size_t WS_W = 2 * MiB, W_LAYER = 26 * MiB;
constexpr size_t WO_IN = 0, WO_OUT = WO_IN + (size_t)INW * D * 2, WO_XQ = WO_OUT + (size_t)D * D * 2, WO_XO = WO_XQ + (size_t)XW * D * 2, WO_UP = WO_XO + (size_t)D * XW * 2, WO_DOWN = WO_UP + (size_t)FF * D * 2;
static_assert(WO_DOWN + (size_t)D * FF * 2 <= W_LAYER, "weights per layer");
constexpr size_t WS_WXKV = WS_W + 2 * W_LAYER;
constexpr size_t WS_SSQ = 56 * MiB;
constexpr size_t WS_MEMN = 68 * MiB;
constexpr size_t WS_KV = 84 * MiB;
constexpr size_t WS_Q2 = 100 * MiB;
constexpr size_t WS_LSE = 132 * MiB;
constexpr size_t WS_XB = 136 * MiB;
constexpr size_t WS_PROJ = 264 * MiB;
constexpr size_t WS_Y = 616 * MiB;
constexpr size_t WS_YA1 = 744 * MiB, WS_YA2 = 776 * MiB;
constexpr size_t WS_H = 264 * MiB;
constexpr size_t WS_END = 808 * MiB;
static_assert(WS_PROJ + (size_t)M * INW * 2 <= WS_Y && WS_H + (size_t)M * FF * 2 <= WS_END && WS_XB + (size_t)M * D * 2 <= WS_PROJ, "d_ws map");
constexpr int CW_TMO = 0, CW_CODE = 1, CW_BAR = 4096;

constexpr int RING_OFF = 0, RING_BYTES = 131072;
constexpr int LDSCTL_OFF = RING_BYTES, MISC_OFF = LDSCTL_OFF + 320;
constexpr int LDS_BYTES = 147456;
__device__ __forceinline__ float wave_sum(float v) {
#pragma unroll
    for (int o = 1; o < 64; o <<= 1) v += __shfl_xor(v, o);
    return v;
}
__device__ __forceinline__ float bf_lo(unsigned u) { return __builtin_bit_cast(float, u << 16); }
__device__ __forceinline__ float bf_hi(unsigned u) { return __builtin_bit_cast(float, u & 0xffff0000u); }
__device__ __forceinline__ float ex2(float x) { return __builtin_amdgcn_exp2f(x); }
__device__ __forceinline__ float lg2(float x) { return __builtin_amdgcn_logf(x); }

__device__ __forceinline__ int rel_bucket(int n) {
    if (n < 16) return n;
    int b = 16;
    b += (n >= 22); b += (n >= 30); b += (n >= 40); b += (n >= 54); b += (n >= 73); b += (n >= 99); b += (n >= 134); b += (n >= 182);
    b += (n >= 246); b += (n >= 332); b += (n >= 450); b += (n >= 609); b += (n >= 825); b += (n >= 1117); b += (n >= 1513);
    return b;
}

__device__ __forceinline__ void p0_transpose_item(const float* W, int K, int N, bf16* WT, const float* g, unsigned qmask, LAS float* scr, int item, int lane) {
    const int nblk = N / 32, kb = item / nblk, nb = item % nblk, k0 = 64 * kb, n0 = 32 * nb;
    const float cs = ((qmask >> (n0 >> 8)) & 1u) ? C2 : 1.0f;
#pragma unroll 8
    for (int i = 0; i < 32; ++i) { const int kk = 2 * i + (lane >> 5); const float gs = g ? g[k0 + kk] * cs : cs; scr[kk * 33 + (lane & 31)] = W[(size_t)(k0 + kk) * N + n0 + (lane & 31)] * gs; }
    LDS_WAIT(); asm volatile("" ::: "memory");
    const int c = lane & 7;
#pragma unroll
    for (int j = 0; j < 4; ++j) { const int n = (lane >> 3) + 8 * j; const LAS float* s = scr + (8 * c) * 33 + n;
        v4u o; o.x = pk2(s[0 * 33], s[1 * 33]); o.y = pk2(s[2 * 33], s[3 * 33]); o.z = pk2(s[4 * 33], s[5 * 33]); o.w = pk2(s[6 * 33], s[7 * 33]);
        *(v4u*)(WT + (size_t)(n0 + n) * K + k0 + 8 * c) = o; }
    LDS_WAIT(); asm volatile("" ::: "memory");
}

struct Frame {
    LAS unsigned char* lds;
    volatile LAS unsigned* MISC;
    gu32* ctl;
    int tid, lane, wave, G;
    const float* const* in;
    float* out;
    unsigned char* ws;
};
#define IN_X 0
#define IN_MEM 1
#define IN_REL 2
#define IN_GMIX 3
#define IN_WIN 4
#define IN_GGRP 5
#define IN_SINK 6
#define IN_WOUT 7
#define IN_GCROSS 8
#define IN_GMEM 9
#define IN_WXQ 10
#define IN_WXKV 11
#define IN_WXO 12
#define IN_GMLP 13
#define IN_WUP 14
#define IN_WDOWN 15
#define IN_GFINAL 16

__device__ __forceinline__ void p0_prologue(Frame& F) {
    LAS float* scr = (LAS float*)(F.lds + RING_OFF + F.wave * 16384);
    const int gw = (int)blockIdx.x * NWAVES + F.wave, NGW = F.G * NWAVES;
    constexpr int I_IN = (D / 64) * (INW / 32), I_OUT = (D / 64) * (D / 32), I_XQ = (D / 64) * (XW / 32), I_XKV = (D / 64) * (512 / 32), I_XO = (XW / 64) * (D / 32), I_UP = (D / 64) * (FF / 32), I_DOWN = (FF / 64) * (D / 32);
    constexpr int I_LAYER = I_IN + I_OUT + I_XQ + I_XKV + I_XO + I_UP + I_DOWN;
    for (int it = gw; it < DEPTH * I_LAYER; it += NGW) {
        const int l = it / I_LAYER; int r = it % I_LAYER;
        unsigned char* wl = F.ws + WS_W + (size_t)l * W_LAYER;
        if (r < I_IN) { p0_transpose_item(F.in[IN_WIN] + (size_t)l * D * INW, D, INW, (bf16*)(wl + WO_IN), F.in[IN_GMIX] + l * D, (1u << 0) | (1u << 3) | (1u << 6) | (1u << 8), scr, r, F.lane); continue; } r -= I_IN;
        if (r < I_OUT) { p0_transpose_item(F.in[IN_WOUT] + (size_t)l * D * D, D, D, (bf16*)(wl + WO_OUT), F.in[IN_GGRP] + l * D, 0u, scr, r, F.lane); continue; } r -= I_OUT;
        if (r < I_XQ) { p0_transpose_item(F.in[IN_WXQ] + (size_t)l * D * XW, D, XW, (bf16*)(wl + WO_XQ), F.in[IN_GCROSS] + l * D, 1u, scr, r, F.lane); continue; } r -= I_XQ;
        if (r < I_XKV) { p0_transpose_item(F.in[IN_WXKV] + (size_t)l * D * 512, D, 512, (bf16*)(F.ws + WS_WXKV) + (size_t)l * 512 * D, F.in[IN_GMEM] + l * D, 0u, scr, r, F.lane); continue; } r -= I_XKV;
        if (r < I_XO) { p0_transpose_item(F.in[IN_WXO] + (size_t)l * XW * D, XW, D, (bf16*)(wl + WO_XO), nullptr, 0u, scr, r, F.lane); continue; } r -= I_XO;
        if (r < I_UP) { p0_transpose_item(F.in[IN_WUP] + (size_t)l * D * FF, D, FF, (bf16*)(wl + WO_UP), F.in[IN_GMLP] + l * D, 0u, scr, r, F.lane); continue; } r -= I_UP;
        p0_transpose_item(F.in[IN_WDOWN] + (size_t)l * FF * D, FF, D, (bf16*)(wl + WO_DOWN), nullptr, 0u, scr, r, F.lane);
    }
    {
        bf16* XB = (bf16*)(F.ws + WS_XB); float* ssq = (float*)(F.ws + WS_SSQ);
        for (int m = gw; m < M; m += NGW) {
            const f32x4* xr = (const f32x4*)(F.in[IN_X] + (size_t)m * D) + F.lane;
            f32x4 v[4]; float s = 0.f;
#pragma unroll
            for (int j = 0; j < 4; ++j) { v[j] = xr[64 * j]; s += (v[j].x * v[j].x + v[j].y * v[j].y) + (v[j].z * v[j].z + v[j].w * v[j].w); }
            s = wave_sum(s);
            unsigned long long* o8 = (unsigned long long*)(XB + (size_t)m * D) + F.lane;
#pragma unroll
            for (int j = 0; j < 4; ++j) o8[64 * j] = (unsigned long long)pk2(v[j].x, v[j].y) | ((unsigned long long)pk2(v[j].z, v[j].w) << 32);
            if (F.lane < 16) ssq[(size_t)m * 16 + F.lane] = (F.lane == 0) ? s : 0.f;
        }
    }
    {
        bf16* MN = (bf16*)(F.ws + WS_MEMN);
        for (int m = gw; m < MROWS; m += NGW) {
            const f32x4* xr = (const f32x4*)(F.in[IN_MEM] + (size_t)m * D) + F.lane;
            f32x4 v[4]; float s = 0.f;
#pragma unroll
            for (int j = 0; j < 4; ++j) { v[j] = xr[64 * j]; s += (v[j].x * v[j].x + v[j].y * v[j].y) + (v[j].z * v[j].z + v[j].w * v[j].w); }
            const float rs = 1.0f / sqrtf(wave_sum(s) * (1.0f / D) + NORM_EPS);
            unsigned long long* o8 = (unsigned long long*)(MN + (size_t)m * D) + F.lane;
#pragma unroll
            for (int j = 0; j < 4; ++j) o8[64 * j] = (unsigned long long)pk2(v[j].x * rs, v[j].y * rs) | ((unsigned long long)pk2(v[j].z * rs, v[j].w * rs) << 32);
        }
    }
    {
        float* bt = (float*)(F.ws + WS_BT);
        for (int i = (int)blockIdx.x * (NWAVES * 64) + F.tid; i < 12 * 2049; i += F.G * NWAVES * 64) {
            const int hh = i / 2049, dist = i % 2049;
            bt[hh * BT_STRIDE + dist] = F.in[IN_REL][rel_bucket(dist) * 12 + hh] * LOG2E;
        }
    }
}
__device__ __forceinline__ float dot64(const float (&q)[64], const bf16* p) {
    const v4u* p4 = (const v4u*)p; float s0 = 0.f, s1 = 0.f;
#pragma unroll
    for (int i = 0; i < 8; ++i) { const v4u w = p4[i];
        s0 += q[8 * i + 0] * bf_lo(w.x); s1 += q[8 * i + 1] * bf_hi(w.x); s0 += q[8 * i + 2] * bf_lo(w.y); s1 += q[8 * i + 3] * bf_hi(w.y);
        s0 += q[8 * i + 4] * bf_lo(w.z); s1 += q[8 * i + 5] * bf_hi(w.z); s0 += q[8 * i + 6] * bf_lo(w.w); s1 += q[8 * i + 7] * bf_hi(w.w); }
    return s0 + s1;
}
__device__ __forceinline__ float dot64f(const float (&q)[64], const float* p) {
    const f32x4* p4 = (const f32x4*)p; float s = 0.f;
#pragma unroll
    for (int i = 0; i < 16; ++i) { const f32x4 w = p4[i]; s += (q[4 * i] * w.x + q[4 * i + 1] * w.y) + (q[4 * i + 2] * w.z + q[4 * i + 3] * w.w); }
    return s;
}
__device__ __forceinline__ void axpby64(float (&o)[64], float f, float a, const bf16* p) {
    const v4u* p4 = (const v4u*)p;
#pragma unroll
    for (int i = 0; i < 8; ++i) { const v4u w = p4[i];
        o[8 * i + 0] = o[8 * i + 0] * f + a * bf_lo(w.x); o[8 * i + 1] = o[8 * i + 1] * f + a * bf_hi(w.x); o[8 * i + 2] = o[8 * i + 2] * f + a * bf_lo(w.y); o[8 * i + 3] = o[8 * i + 3] * f + a * bf_hi(w.y);
        o[8 * i + 4] = o[8 * i + 4] * f + a * bf_lo(w.z); o[8 * i + 5] = o[8 * i + 5] * f + a * bf_hi(w.z); o[8 * i + 6] = o[8 * i + 6] * f + a * bf_lo(w.w); o[8 * i + 7] = o[8 * i + 7] * f + a * bf_hi(w.w); }
}
__device__ __forceinline__ void load_q64(float (&q)[64], const bf16* p) {
    const v4u* p4 = (const v4u*)p;
#pragma unroll
    for (int i = 0; i < 8; ++i) { const v4u w = p4[i];
        q[8 * i + 0] = bf_lo(w.x); q[8 * i + 1] = bf_hi(w.x); q[8 * i + 2] = bf_lo(w.y); q[8 * i + 3] = bf_hi(w.y); q[8 * i + 4] = bf_lo(w.z); q[8 * i + 5] = bf_hi(w.z); q[8 * i + 6] = bf_lo(w.w); q[8 * i + 7] = bf_hi(w.w); }
}
__device__ __forceinline__ void store_o64(bf16* p, const float (&o)[64], float sc) {
    v4u* p4 = (v4u*)p;
#pragma unroll
    for (int i = 0; i < 8; ++i) { v4u w; w.x = pk2(o[8 * i] * sc, o[8 * i + 1] * sc); w.y = pk2(o[8 * i + 2] * sc, o[8 * i + 3] * sc); w.z = pk2(o[8 * i + 4] * sc, o[8 * i + 5] * sc); w.w = pk2(o[8 * i + 6] * sc, o[8 * i + 7] * sc); p4[i] = w; }
}
#define NV_SOFTMAX_STEP(s2, vptr) do { const float mn_ = __builtin_fmaxf(mrun, (s2)); const float f_ = ex2(mrun - mn_), p_ = ex2((s2) - mn_); lrun = lrun * f_ + p_; axpby64(o, f_, p_, (vptr)); mrun = mn_; } while (0)

__device__ __forceinline__ void naive_A(const bf16* proj, bf16* Y, const float* bt, int b, int h, int t) {
    const size_t rowb = (size_t)b * SEQ; float q[64], o[64];
    load_q64(q, proj + (rowb + t) * INW + COL_AQ + h * 64);
#pragma unroll
    for (int i = 0; i < 64; ++i) o[i] = 0.f;
    float mrun = -1e30f, lrun = 0.f; const float* bth = bt + h * BT_STRIDE;
    for (int c = 0; c < 3; ++c) { const int d = (c == 0) ? 1 : (c == 1) ? 4 : 16;
        for (int dl = 0; dl <= 128; ++dl) { const int s = t - dl * d; if (s < 0) break;
            const bf16* kr = proj + (rowb + s) * INW;
            const float s2 = dot64(q, kr + COL_AK + h * 64) + bth[dl * d];
            NV_SOFTMAX_STEP(s2, kr + COL_AV + h * 64); } }
    store_o64(Y + (rowb + t) * D + 0 + h * 64, o, 1.0f / lrun);
}
__device__ __forceinline__ void naive_C(const bf16* proj, bf16* Y, const float* bt, const float* sinks, int b, int h, int t) {
    const size_t rowb = (size_t)b * SEQ; float q[64], o[64]; const int g = h >> 1;
    load_q64(q, proj + (rowb + t) * INW + COL_CQ + h * 64);
#pragma unroll
    for (int i = 0; i < 64; ++i) o[i] = 0.f;
    float mrun = sinks[h] * LOG2E, lrun = 1.0f; const float* bth = bt + (4 + h) * BT_STRIDE;
    for (int dl = 0; dl < 128; ++dl) { const int s = t - dl; if (s < 0) break;
        const bf16* kr = proj + (rowb + s) * INW;
        const float s2 = dot64(q, kr + COL_CK + g * 64) + bth[dl];
        NV_SOFTMAX_STEP(s2, kr + COL_CV + g * 64); }
    store_o64(Y + (rowb + t) * D + 512 + h * 64, o, 1.0f / lrun);
}
__device__ __forceinline__ void naive_B(const bf16* proj, bf16* Y, int b, int h, int t, int tmax) {
    const size_t rowb = (size_t)b * SEQ; float q[64], o[64];
    load_q64(q, proj + (rowb + t) * INW + COL_BQ + h * 64);
#pragma unroll
    for (int i = 0; i < 64; ++i) o[i] = 0.f;
    float c = 0.f;
    for (int s = tmax - 1; s >= 0; --s) {
        const bf16* kr = proj + (rowb + s) * INW;
        if (s < t) {
            const float z2 = dot64(q, kr + COL_BK + h * 64);
            const float sp = __builtin_fmaxf(z2, 0.f) + lg2(1.0f + ex2(-__builtin_fabsf(z2)));
            const float a = ex2(z2 - sp - c);
            axpby64(o, 1.0f, a, kr + COL_BV + h * 64);
            c += sp;
        }
        if (__all(c > 160.f)) break;
    }
    store_o64(Y + (rowb + t) * D + 256 + h * 64, o, 1.0f);
}
__device__ __forceinline__ void naive_D(const bf16* proj, bf16* Y, const float* bt, const float* kmean, int b, int h, int t, int tmax) {
    const size_t rowb = (size_t)b * SEQ; float q[64], o[64];
    load_q64(q, proj + (rowb + t) * INW + COL_DQ + h * 64);
#pragma unroll
    for (int i = 0; i < 64; ++i) o[i] = 0.f;
    const int qb = t >> 8;
    float gate[8]; const float* km = kmean + (size_t)(b * 4 + h) * 8 * 64;
#pragma unroll
    for (int n = 0; n < 8; ++n) gate[n] = (n < qb) ? dot64f(q, km + n * 64) : -3e38f;
    unsigned sel = 0u;
#pragma unroll
    for (int n = 0; n < 8; ++n) { int rank = 0;
#pragma unroll
        for (int n2 = 0; n2 < 8; ++n2) rank += (n2 != n) && ((gate[n2] > gate[n]) || (gate[n2] == gate[n] && n2 < n));
        if (n < qb && rank < 3) sel |= 1u << n; }
    float mrun = -1e30f, lrun = 0.f; const float* bth = bt + (8 + h) * BT_STRIDE;
    for (int blk = 0; blk <= qb; ++blk) {
        const bool use = (blk == qb) || ((sel >> blk) & 1u);
        if (!__any(use)) continue;
        const int s1 = (blk == qb) ? tmax : blk * 256 + 255;
        for (int s = blk * 256; s <= s1; ++s) {
            if (use && s <= t) {
                const bf16* kr = proj + (rowb + s) * INW;
                const float s2 = dot64(q, kr + COL_DK + h * 64) + bth[t - s];
                NV_SOFTMAX_STEP(s2, kr + COL_DV + h * 64);
            }
        }
    }
    store_o64(Y + (rowb + t) * D + 768 + h * 64, o, 1.0f / lrun);
}
__device__ __forceinline__ void naive_X(bf16* Q2, const bf16* KV, int l, int b, int h, int t) {
    float q[64], o[64]; bf16* qp = Q2 + ((size_t)b * SEQ + t) * XW + h * 64;
    load_q64(q, qp);
#pragma unroll
    for (int i = 0; i < 64; ++i) o[i] = 0.f;
    float mrun = -1e30f, lrun = 0.f;
    for (int mm = 0; mm < MEMLEN; ++mm) {
        const bf16* kr = KV + ((size_t)b * MEMLEN + mm) * 1024 + l * 512 + h * 64;
        const float s2 = dot64(q, kr);
        NV_SOFTMAX_STEP(s2, kr + 256);
    }
    store_o64(qp, o, 1.0f / lrun);
}
__device__ __forceinline__ void k1_kmean(Frame& F) {
    const bf16* proj = (const bf16*)(F.ws + WS_PROJ); float* kmean = (float*)(F.ws + WS_KMEAN);
    LAS float* red = (LAS float*)(F.lds + RING_OFF);
    for (int u = (int)blockIdx.x; u < BATCH * 8; u += F.G) {
        const int b = u >> 3, blk = u & 7, cp = F.tid & 127, part = F.tid >> 7;
        const unsigned* src = (const unsigned*)(proj + ((size_t)b * SEQ + blk * 256 + part * 64) * INW + COL_DK) + cp;
        float s0 = 0.f, s1 = 0.f;
#pragma unroll 8
        for (int r = 0; r < 64; ++r) { const unsigned w = src[(size_t)r * (INW / 2)]; s0 += bf_lo(w); s1 += bf_hi(w); }
        red[part * 256 + 2 * cp] = s0; red[part * 256 + 2 * cp + 1] = s1;
        __syncthreads();
        if (F.tid < 256) { const float s = (red[F.tid] + red[256 + F.tid]) + (red[512 + F.tid] + red[768 + F.tid]);
            kmean[((size_t)(b * 4 + (F.tid >> 6)) * 8 + blk) * 64 + (F.tid & 63)] = s * (1.0f / 256.0f); }
        __syncthreads();
    }
}
template <bool MERGE> __device__ __forceinline__ void nm_groupnorm(Frame& F) {
    bf16* Y = (bf16*)(F.ws + WS_Y); const bf16* YA1 = (const bf16*)(F.ws + WS_YA1); const bf16* YA2 = (const bf16*)(F.ws + WS_YA2); const float* lse = (const float*)(F.ws + WS_LSE);
    const int gw = (int)blockIdx.x * NWAVES + F.wave, NGW = F.G * NWAVES;
    for (int row = gw; row < M; row += NGW) {
#pragma unroll
        for (int g = 0; g < 4; ++g) {
            unsigned long long* yp = (unsigned long long*)(Y + (size_t)row * D + g * 256) + F.lane;
            const unsigned long long w = *yp;
            float v0 = bf_lo((unsigned)w), v1 = bf_hi((unsigned)w), v2 = bf_lo((unsigned)(w >> 32)), v3 = bf_hi((unsigned)(w >> 32));
            if (MERGE && g == 0) {
                const int hh = F.lane >> 4;
                const float l0 = lse[(size_t)row * 4 + hh], l1 = lse[(size_t)(M + row) * 4 + hh], l2 = lse[(size_t)(2 * M + row) * 4 + hh];
                const float mx = __builtin_fmaxf(l0, __builtin_fmaxf(l1, l2));
                const float w0 = ex2(l0 - mx), w1 = ex2(l1 - mx), w2 = ex2(l2 - mx), inv = 1.0f / (w0 + w1 + w2);
                const unsigned long long a = *((const unsigned long long*)(YA1 + (size_t)row * 256) + F.lane), c = *((const unsigned long long*)(YA2 + (size_t)row * 256) + F.lane);
                v0 = (w0 * v0 + w1 * bf_lo((unsigned)a) + w2 * bf_lo((unsigned)c)) * inv; v1 = (w0 * v1 + w1 * bf_hi((unsigned)a) + w2 * bf_hi((unsigned)c)) * inv;
                v2 = (w0 * v2 + w1 * bf_lo((unsigned)(a >> 32)) + w2 * bf_lo((unsigned)(c >> 32))) * inv; v3 = (w0 * v3 + w1 * bf_hi((unsigned)(a >> 32)) + w2 * bf_hi((unsigned)(c >> 32))) * inv;
            }
            const float ss = wave_sum((v0 * v0 + v1 * v1) + (v2 * v2 + v3 * v3));
            const float rs = 1.0f / sqrtf(ss * (1.0f / 256.0f) + NORM_EPS);
            *yp = (unsigned long long)pk2(v0 * rs, v1 * rs) | ((unsigned long long)pk2(v2 * rs, v3 * rs) << 32);
        }
    }
}
__device__ __forceinline__ void fn_finalnorm(Frame& F, const float* ssq) {
    const int gw = (int)blockIdx.x * NWAVES + F.wave, NGW = F.G * NWAVES;
    const f32x4* gf = (const f32x4*)F.in[IN_GFINAL] + F.lane;
    f32x4 gv[4];
#pragma unroll
    for (int j = 0; j < 4; ++j) gv[j] = gf[64 * j];
    for (int row = gw; row < M; row += NGW) {
        float s = (F.lane < 16) ? ssq[(size_t)row * 16 + F.lane] : 0.f;
        s = wave_sum(s);
        const float rs = 1.0f / sqrtf(s * (1.0f / D) + NORM_EPS);
        f32x4* xr = (f32x4*)(F.out + (size_t)row * D) + F.lane;
#pragma unroll
        for (int j = 0; j < 4; ++j) { const f32x4 v = xr[64 * j]; xr[64 * j] = v * rs * gv[j]; }
    }
}
__device__ __forceinline__ void at_naive(Frame& F, int l) {
    const bf16* proj = (const bf16*)(F.ws + WS_PROJ); bf16* Y = (bf16*)(F.ws + WS_Y); const float* bt = (const float*)(F.ws + WS_BT); const float* kmean = (const float*)(F.ws + WS_KMEAN);
    const float* sinks = F.in[IN_SINK] + l * 4;
    constexpr int NCH = 4 * BATCH * 4 * 4;
    for (int c = (int)blockIdx.x; c < NCH; c += F.G) {
        const int mixer = c >> 9, b = (c >> 4) & 31, h = (c >> 2) & 3, tq = ((c & 3) + (c >> 8)) & 3;
        const int t = tq * 512 + F.tid, tmax = tq * 512 + F.wave * 64 + 63;
        if (mixer == 0) naive_D(proj, Y, bt, kmean, b, h, t, tmax);
        else if (mixer == 1) naive_B(proj, Y, b, h, t, tmax);
        else if (mixer == 2) naive_A(proj, Y, bt, b, h, t);
        else naive_C(proj, Y, bt, sinks, b, h, t);
    }
}
__device__ __forceinline__ void xa_naive(Frame& F, int l) {
    bf16* Q2 = (bf16*)(F.ws + WS_Q2); const bf16* KV = (const bf16*)(F.ws + WS_KV);
    constexpr int NCH = BATCH * 4 * 4;
    for (int c = (int)blockIdx.x; c < NCH; c += F.G) {
        const int b = c >> 4, h = (c >> 2) & 3, tq = c & 3;
        naive_X(Q2, KV, l, b, h, tq * 512 + F.tid);
    }
}

constexpr int PH_P0 = 0, PH_GKV = 1, PH_L0 = 2, PH_PER_LAYER = 10, PH_FN = PH_L0 + DEPTH * PH_PER_LAYER, NPHASE = PH_FN + 1;
#ifndef T_DEPTH
#define T_DEPTH DEPTH
#endif
#ifndef MK_SPLIT
#define MK_SPLIT 1
#endif
#define IN(k) (lo <= (k) && (k) < hi)
#define SEAM(k) do { if (IN(k) && IN((k) + 1)) xcd_barrier(bar); } while (0)
template <int l> __device__ __forceinline__ void layer_phases(Frame& F, const XcdBarrier& bar, const int lo, const int hi) {
    unsigned char* ws = F.ws;
        const int pb = PH_L0 + l * PH_PER_LAYER;
        const unsigned char* wl = ws + WS_W + (size_t)l * W_LAYER;
        float* ssqA = (float*)(ws + WS_SSQ); float* ssqB = ssqA + (size_t)M * 16; float* ssqC = ssqB + (size_t)M * 16;
        if (IN(pb + 0)) {
            pg8::Gemm g{(const bf16*)(ws + WS_XB), (const bf16*)(wl + WO_IN), M, INW, D}; pg8::StaticOrder S; S.init(M, INW, F.G, (int)blockIdx.x);
            pg8::EpiRowScale<0> E{(bf16*)(ws + WS_PROJ), INW, ssqA};
            pg8::gemm_phase<pg8::EpiRowScale<0>, pg8::StaticOrder, true, true>(F.lds + RING_OFF, g, S, E);
        }
        SEAM(pb + 0);
        if (IN(pb + 1)) { k1_kmean(F); }
        SEAM(pb + 1);
        if (IN(pb + 2)) {
#ifndef T_NO_NAIVE
 at_naive(F, l);
#endif
 }
        SEAM(pb + 2);
        if (IN(pb + 3)) { nm_groupnorm<false>(F); }
        SEAM(pb + 3);
        if (IN(pb + 4)) {
            pg8::Gemm g{(const bf16*)(ws + WS_Y), (const bf16*)(wl + WO_OUT), M, D, D}; pg8::StaticOrder S; S.init(M, D, F.G, (int)blockIdx.x);
            pg8::EpiResid E{l == 0 ? F.in[IN_X] : (const float*)F.out, F.out, (bf16*)(ws + WS_XB), ssqB};
            pg8::gemm_phase<pg8::EpiResid, pg8::StaticOrder, true, true>(F.lds + RING_OFF, g, S, E);
        }
        SEAM(pb + 4);
        if (IN(pb + 5)) {
            pg8::Gemm g{(const bf16*)(ws + WS_XB), (const bf16*)(wl + WO_XQ), M, XW, D}; pg8::StaticOrder S; S.init(M, XW, F.G, (int)blockIdx.x);
            pg8::EpiRowScale<0> E{(bf16*)(ws + WS_Q2), XW, ssqB};
            pg8::gemm_phase<pg8::EpiRowScale<0>, pg8::StaticOrder, true, true>(F.lds + RING_OFF, g, S, E);
        }
        SEAM(pb + 5);
        if (IN(pb + 6)) {
#ifndef T_NO_NAIVE
 xa_naive(F, l);
#endif
 }
        SEAM(pb + 6);
        if (IN(pb + 7)) {
            pg8::Gemm g{(const bf16*)(ws + WS_Q2), (const bf16*)(wl + WO_XO), M, D, XW}; pg8::StaticOrder S; S.init(M, D, F.G, (int)blockIdx.x);
            pg8::EpiResid E{(const float*)F.out, F.out, (bf16*)(ws + WS_XB), ssqC};
            pg8::gemm_phase<pg8::EpiResid, pg8::StaticOrder, true, true>(F.lds + RING_OFF, g, S, E);
        }
        SEAM(pb + 7);
        if (IN(pb + 8)) {
            pg8::Gemm g{(const bf16*)(ws + WS_XB), (const bf16*)(wl + WO_UP), M, FF, D}; pg8::StaticOrder S; S.init(M, FF, F.G, (int)blockIdx.x);
            pg8::EpiRowScale<1> E{(bf16*)(ws + WS_H), FF, ssqC};
            pg8::gemm_phase<pg8::EpiRowScale<1>, pg8::StaticOrder, true, true>(F.lds + RING_OFF, g, S, E);
        }
        SEAM(pb + 8);
        if (IN(pb + 9)) {
            pg8::Gemm g{(const bf16*)(ws + WS_H), (const bf16*)(wl + WO_DOWN), M, D, FF}; pg8::StaticOrder S; S.init(M, D, F.G, (int)blockIdx.x);
            pg8::EpiResid E{(const float*)F.out, F.out, (bf16*)(ws + WS_XB), ssqA};
            pg8::gemm_phase<pg8::EpiResid, pg8::StaticOrder, true, true>(F.lds + RING_OFF, g, S, E);
        }
        SEAM(pb + 9);
}
#undef IN
#undef SEAM
struct Args { const float* in[17]; float* out; unsigned char* ws; int ph_lo, ph_hi; };
__global__ void __launch_bounds__(NWAVES * 64, 2) mk_fwd(Args args) {
    extern __shared__ __attribute__((aligned(16))) unsigned char lds[];
    Frame F;
    F.lds = (LAS unsigned char*)lds;
    F.MISC = (volatile LAS unsigned*)(F.lds + MISC_OFF);
    F.tid = threadIdx.x; F.lane = F.tid & 63; F.wave = __builtin_amdgcn_readfirstlane(F.tid >> 6);
    F.G = gridDim.x;
    unsigned char* ws = args.ws; F.ws = ws; F.out = args.out;
    F.ctl = (gu32*)(ws + WS_CTL);
    F.in = args.in;
    for (int u = F.tid; u < (LDS_BYTES - LDSCTL_OFF) / 4; u += NWAVES * 64) ((LAS unsigned*)(F.lds + LDSCTL_OFF))[u] = 0u;
    __syncthreads();
    XcdBarrier bar; bar.bar = (unsigned*)(F.ctl + CW_BAR); bar.x = 0; bar.st = nullptr;
    if (!MK_SPLIT) bar = xcd_barrier_post((unsigned*)(F.ctl + CW_BAR), F.MISC + 8);
    const int lo = args.ph_lo, hi = args.ph_hi;
#define IN(k) (lo <= (k) && (k) < hi)
#define SEAM(k) do { if (IN(k) && IN((k) + 1)) xcd_barrier(bar); } while (0)

    if (IN(PH_P0)) { p0_prologue(F); }
    SEAM(PH_P0);
    if (IN(PH_GKV)) {
        pg8::Gemm g{(const bf16*)(ws + WS_MEMN), (const bf16*)(ws + WS_WXKV), MROWS, 1024, D}; pg8::StaticOrder S; S.init(MROWS, 1024, F.G, (int)blockIdx.x);
        pg8::EpiRowScale<0> E{(bf16*)(ws + WS_KV), 1024, nullptr};
        pg8::gemm_phase<pg8::EpiRowScale<0>, pg8::StaticOrder, true, true>(F.lds + RING_OFF, g, S, E);
    }
    SEAM(PH_GKV);
    layer_phases<0>(F, bar, lo, hi);
    if (T_DEPTH > 1) layer_phases<1>(F, bar, lo, hi);
    if (IN(PH_FN)) { fn_finalnorm(F, (const float*)(ws + WS_SSQ)); }
#undef IN
#undef SEAM
}

extern "C" void kernel_launch(void* const* d_in, const int* in_sizes, int n_in, void* d_out, int out_size, void* d_ws, size_t ws_size, hipStream_t stream) {
    static int grid = 0;
    if (grid == 0) {
        if (n_in != 17 || in_sizes[0] != M * D || out_size != M * D || ws_size < WS_END) { fprintf(stderr, "kernel_launch: unexpected shapes (n_in %d, in0 %d, out %d, ws %zu); nothing launched\n", n_in, n_in > 0 ? in_sizes[0] : -1, out_size, ws_size); grid = -1; return; }
        int dev = 0, cus = 0, per_cu = 0;
        if (hipGetDevice(&dev) != hipSuccess || hipDeviceGetAttribute(&cus, hipDeviceAttributeMultiprocessorCount, dev) != hipSuccess) { grid = -1; return; }
        if (hipFuncSetAttribute((const void*)mk_fwd, hipFuncAttributeMaxDynamicSharedMemorySize, LDS_BYTES) != hipSuccess) { grid = -1; return; }
        if (hipOccupancyMaxActiveBlocksPerMultiprocessor(&per_cu, (const void*)mk_fwd, NWAVES * 64, LDS_BYTES) != hipSuccess || per_cu < 1) { fprintf(stderr, "kernel_launch: occupancy query says %d\n", per_cu); }
        (void)hipGetLastError();
        grid = cus;
    }
    if (grid < 0) return;
    if (hipMemsetAsync((char*)d_ws + WS_CTL, 0, CTL_ZERO_BYTES, stream) != hipSuccess) return;
    Args a{};
    for (int i = 0; i < 17; ++i) a.in[i] = (const float*)d_in[i];
    a.out = (float*)d_out; a.ws = (unsigned char*)d_ws;
#if MK_SPLIT
    for (int p = 0; p < NPHASE; ++p) { a.ph_lo = p; a.ph_hi = p + 1; hipLaunchKernelGGL(mk_fwd, dim3(grid), dim3(NWAVES * 64), LDS_BYTES, stream, a); }
#else
    a.ph_lo = 0; a.ph_hi = NPHASE; hipLaunchKernelGGL(mk_fwd, dim3(grid), dim3(NWAVES * 64), LDS_BYTES, stream, a);
#endif
}
```

```cpp
#include <hip/hip_runtime.h>
#include <cstdio>
#include <cstdint>
namespace pg8 {
#define PG8_LAS __attribute__((address_space(3)))
typedef unsigned short bf16_t;
typedef short bf16x8 __attribute__((ext_vector_type(8)));
typedef float f32x4 __attribute__((ext_vector_type(4)));
typedef unsigned u32x4 __attribute__((ext_vector_type(4)));
constexpr int BM = 256, BK = 64, HALF = 128, HTB = HALF * BK * 2  , STAGE_BYTES = 8 * HTB, NXCD = 8, WGM = 8;

__host__ __device__ __forceinline__ int lds_byte(int r, int c) { return r * 128 + ((((c >> 3) ^ ((r >> 1) & 7))) << 4) + (c & 7) * 2; }
__host__ __device__ __forceinline__ void stage_rc(int b, int& R, int& C) { R = b >> 7; C = ((((b & 127) >> 4) ^ ((R >> 1) & 7))) * 8; }
__host__ __device__ __forceinline__ int perm32(int rho) { const int n = rho >> 4, i = rho & 15; return 8 * (i >> 2) + 4 * n + (i & 3); }

struct Unit { int pm, pn; };
struct Gemm { const bf16_t* A; const bf16_t* Bt; int M, N, K; const float* hr = nullptr; };

struct StaticOrder {
    int nM, nN, nwg, G, c;
    __host__ __device__ void init(int M, int N, int G_, int c_) { nM = M / BM; nN = N / BM; nwg = nM * nN; G = G_; c = c_; }
    __host__ __device__ bool next(int i, Unit& u) const {
        const long L = (long)i * G + c; if (L >= nwg) return false;
        int wgid = (int)L; { const int q = nwg / NXCD, r = nwg % NXCD, xcd = wgid % NXCD, off = wgid / NXCD; wgid = (xcd < r ? xcd * (q + 1) : r * (q + 1) + (xcd - r) * q) + off; }
        const int nig = WGM * nN, gid = wgid / nig, fm = gid * WGM, gsz = (nM - fm) < WGM ? (nM - fm) : WGM;
        u.pm = fm + ((wgid % nig) % gsz); u.pn = (wgid % nig) / gsz; return true;
    }
    __device__ __forceinline__ void a_ready(const Unit&) const {}
    __device__ __forceinline__ void done(const Unit&) const {}
};

struct PanelOrder {
    int pm, nN;
    __device__ __forceinline__ bool next(int i, Unit& u) const { if (i >= nN) return false; u.pm = pm; u.pn = i; return true; }
    __device__ __forceinline__ void a_ready(const Unit&) const {}
    __device__ __forceinline__ void done(const Unit&) const {}
};

__device__ __forceinline__ unsigned cvt_pk_bf16(float lo, float hi) { unsigned r; asm volatile("v_cvt_pk_bf16_f32 %0, %1, %2" : "=v"(r) : "v"(lo), "v"(hi)); return r; }
typedef float f32x2 __attribute__((ext_vector_type(2)));
constexpr float RMS_EPS = 1e-6f;
__device__ __forceinline__ float row_rs(const float* ssq, int row) {
    const f32x4* p = (const f32x4*)(ssq + (size_t)row * 16);
    const f32x4 a = p[0], b = p[1], c = p[2], d = p[3];
    const float s = (((a[0] + a[1]) + (a[2] + a[3])) + ((b[0] + b[1]) + (b[2] + b[3]))) + (((c[0] + c[1]) + (c[2] + c[3])) + ((d[0] + d[1]) + (d[2] + d[3])));
    return __builtin_amdgcn_rsqf(s * (1.0f / 1024.0f) + RMS_EPS);
}
template <int ACT, bool NT = false> struct EpiRowScale {
    static constexpr bool PERM = true, AFTER_DRAIN = false; static constexpr int MIN_VMEM = 16;
    bf16_t* O; int ldc; const float* ssq; float* kmp;
    __device__ __forceinline__ void operator()(const f32x4 (&acc)[2][2][4][2], const Unit& u, int wr, int wc, int fr, int fq) const {
        const int row0 = u.pm * BM + wr * 64 + fr, col0 = u.pn * BM + wc * 64 + 8 * fq;
        float rs[2][4];
        if (ssq) {
            f32x4 q4[2][4];
#pragma unroll
            for (int ai = 0; ai < 2; ++ai)
#pragma unroll
                for (int m = 0; m < 4; ++m) q4[ai][m] = *(const f32x4*)(ssq + (size_t)(row0 + ai * HALF + m * 16) * 16 + 4 * fq);
#pragma unroll
            for (int ai = 0; ai < 2; ++ai)
#pragma unroll
                for (int m = 0; m < 4; ++m) { float s = (q4[ai][m][0] + q4[ai][m][1]) + (q4[ai][m][2] + q4[ai][m][3]); s += __shfl_xor(s, 16); s += __shfl_xor(s, 32);
                    rs[ai][m] = __builtin_amdgcn_rsqf(s * (1.0f / 1024.0f) + RMS_EPS); }
        } else {
#pragma unroll
            for (int ai = 0; ai < 2; ++ai)
#pragma unroll
                for (int m = 0; m < 4; ++m) rs[ai][m] = 1.0f;
        }
        if (ACT == 0 && kmp != nullptr && u.pn == 9) {
#pragma unroll
            for (int bj = 0; bj < 2; ++bj)
#pragma unroll
                for (int n = 0; n < 2; ++n) {
                    f32x4 cs = {0.f, 0.f, 0.f, 0.f};
#pragma unroll
                    for (int ai = 0; ai < 2; ++ai)
#pragma unroll
                        for (int m = 0; m < 4; ++m) { float rk = rs[ai][m]; asm volatile("" : "+v"(rk)); cs += acc[ai][bj][m][n] * rk; }
#pragma unroll
                    for (int e = 0; e < 4; ++e) { float v = cs[e]; v += __shfl_xor(v, 1); v += __shfl_xor(v, 2); v += __shfl_xor(v, 4); v += __shfl_xor(v, 8); cs[e] = v; }
                    if (fr == 0) *(f32x4*)(kmp + ((size_t)u.pm * 2 + wr) * 256 + wc * 64 + bj * 32 + 8 * fq + 4 * n) = cs;
                }
        }
        const int odd = fr & 1;
        bf16_t* pbase = O + (size_t)(row0 - odd) * ldc + col0 + odd * 32;
#pragma unroll
        for (int ai = 0; ai < 2; ++ai)
#pragma unroll
            for (int m = 0; m < 4; ++m) {
                u32x4 w[2];
#pragma unroll
                for (int bj = 0; bj < 2; ++bj) {
                    f32x4 v0 = acc[ai][bj][m][0] * rs[ai][m], v1 = acc[ai][bj][m][1] * rs[ai][m];
                    if (ACT == 1) {
#pragma unroll
                        for (int e = 0; e < 4; ++e) { const float a = __builtin_fmaxf(v0[e], 0.f), b = __builtin_fmaxf(v1[e], 0.f); v0[e] = a * a; v1[e] = b * b; }
                    }
                    w[bj].x = cvt_pk_bf16(v0[0], v0[1]); w[bj].y = cvt_pk_bf16(v0[2], v0[3]); w[bj].z = cvt_pk_bf16(v1[0], v1[1]); w[bj].w = cvt_pk_bf16(v1[2], v1[3]);
                }
                const u32x4 snd = odd ? w[0] : w[1]; u32x4 rcv;
#pragma unroll
                for (int e = 0; e < 4; ++e) rcv[e] = (unsigned)__builtin_amdgcn_update_dpp(0, (int)snd[e], 0xB1, 0xF, 0xF, true);
                bf16_t* p = pbase + (size_t)(ai * HALF + m * 16) * ldc;
                if (NT) { __builtin_nontemporal_store(odd ? rcv : w[0], (u32x4*)p); __builtin_nontemporal_store(odd ? w[1] : rcv, (u32x4*)(p + ldc)); }
                else { *(u32x4*)p = odd ? rcv : w[0]; *(u32x4*)(p + ldc) = odd ? w[1] : rcv; }
            }
    }
};
template <bool DEEP> struct EpiResid {
    static constexpr bool PERM = true, AFTER_DRAIN = false; static constexpr int MIN_VMEM = 16;
    bf16_t* xb; float* ssq;
    __device__ __forceinline__ void operator()(const f32x4 (&acc)[2][2][4][2], const Unit& u, int wr, int wc, int fr, int fq) const {
        const int row0 = u.pm * BM + wr * 64 + fr, col0 = u.pn * BM + wc * 64 + 8 * fq, slot = u.pn * 4 + wc;
        char* const xbase = (char*)xb; char* const sbase = (char*)ssq;
        const int odd = fr & 1;
        const unsigned xoff0 = ((unsigned)(row0 - odd) * 1024u + (unsigned)(col0 + odd * 32)) * 2u, soff0 = ((unsigned)row0 * 16u + (unsigned)slot) * 4u;
#define ERL(dst, am_) do { _Pragma("unroll") for (int mm = 0; mm < 2; ++mm) _Pragma("unroll") for (int rr = 0; rr < 2; ++rr) \
            dst[mm][rr] = *(const u32x4*)(xbase + (xoff0 + (unsigned)((((am_) >> 1) * HALF + (((am_) & 1) * 2 + mm) * 16 + rr) * 2048))); } while (0)
#define EDPP(x) ((unsigned)__builtin_amdgcn_update_dpp(0, (int)(x), 0xB1, 0xF, 0xF, true))
        u32x4 xin[2][2], xnx[2][2];
        ERL(xin, 0);
#pragma unroll
        for (int am = 0; am < 4; ++am) {
            const int ai = am >> 1;
            if (DEEP) { if (am < 3) ERL(xnx, am + 1); }
#pragma unroll
            for (int mm = 0; mm < 2; ++mm) {
                const int m = (am & 1) * 2 + mm;
                const u32x4 la = xin[mm][0], lb = xin[mm][1];
                const u32x4 snd = odd ? la : lb; u32x4 rcv;
#pragma unroll
                for (int e = 0; e < 4; ++e) rcv[e] = EDPP(snd[e]);
                const u32x4 b0 = odd ? rcv : la, b1 = odd ? lb : rcv;
                u32x4 w[2]; float ss = 0.f;
#pragma unroll
                for (int bj = 0; bj < 2; ++bj) {
                    const u32x4 b = bj ? b1 : b0;
                    const f32x4 a0 = acc[ai][bj][m][0], a1 = acc[ai][bj][m][1];
                    w[bj].x = cvt_pk_bf16(a0[0] + __builtin_bit_cast(float, b.x << 16), a0[1] + __builtin_bit_cast(float, b.x & 0xffff0000u));
                    w[bj].y = cvt_pk_bf16(a0[2] + __builtin_bit_cast(float, b.y << 16), a0[3] + __builtin_bit_cast(float, b.y & 0xffff0000u));
                    w[bj].z = cvt_pk_bf16(a1[0] + __builtin_bit_cast(float, b.z << 16), a1[1] + __builtin_bit_cast(float, b.z & 0xffff0000u));
                    w[bj].w = cvt_pk_bf16(a1[2] + __builtin_bit_cast(float, b.w << 16), a1[3] + __builtin_bit_cast(float, b.w & 0xffff0000u));
#pragma unroll
                    for (int e = 0; e < 4; ++e) { const float lo = __builtin_bit_cast(float, w[bj][e] << 16), hi = __builtin_bit_cast(float, w[bj][e] & 0xffff0000u); ss += lo * lo + hi * hi; }
                }
                const u32x4 snd2 = odd ? w[0] : w[1]; u32x4 rcv2;
#pragma unroll
                for (int e = 0; e < 4; ++e) rcv2[e] = EDPP(snd2[e]);
                char* p = xbase + (xoff0 + (unsigned)((ai * HALF + m * 16) * 2048));
                if (DEEP) { __builtin_nontemporal_store(odd ? rcv2 : w[0], (u32x4*)p); __builtin_nontemporal_store(odd ? w[1] : rcv2, (u32x4*)(p + 2048)); }
                else { *(u32x4*)p = odd ? rcv2 : w[0]; *(u32x4*)(p + 2048) = odd ? w[1] : rcv2; }
                ss += __shfl_xor(ss, 16); ss += __shfl_xor(ss, 32);
                if (fq == 0) *(float*)(sbase + (soff0 + (unsigned)((ai * HALF + m * 16) * 64))) = ss;
            }
            asm volatile("" ::: "memory");
            if (DEEP) {
#pragma unroll
                for (int mm = 0; mm < 2; ++mm)
#pragma unroll
                    for (int rr = 0; rr < 2; ++rr) xin[mm][rr] = xnx[mm][rr];
            } else { if (am < 3) ERL(xin, am + 1); }
        }
#undef EDPP
#undef ERL
    }
};

__device__ __forceinline__ int pg8_lane_id() { int l; asm volatile("v_mbcnt_lo_u32_b32 %0, -1, 0\n\tv_mbcnt_hi_u32_b32 %0, -1, %0" : "=v"(l)); return l; }
template <class Epi, class Sched, bool ALIGN_EPI = false, bool SP2 = false, bool HORNER = false>
__device__ __forceinline__ void gemm_phase(PG8_LAS unsigned char* lds, const Gemm g, const Sched& S, const Epi& E, const int wave_) {
    const int wid = wave_, lane = pg8_lane_id(), tid = wid * 64 + lane, wr = wid >> 2, wc = wid & 3, fr = lane & 15, fq = lane >> 4;
    const int K = g.K, nt = K / BK;
    unsigned voffA, voffB;
    { int R, C; stage_rc(tid * 16, R, C); const int Rb = 64 * (R >> 5) + perm32(R & 31);
      voffA = (unsigned)(R * K + C) * 2u; voffB = (unsigned)(Rb * K + C) * 2u; }
    const size_t pstepA = (size_t)64 * K * 2, pstepB = (size_t)128 * K * 2, hstepB = (size_t)32 * K * 2;
    const size_t kstep = (size_t)(BK * 2);
    const size_t hstep = (size_t)HALF * K * 2;
    const size_t tstep = 2 * hstep;
    const unsigned ldsw = (unsigned)wid * 1024u;
    const int aoff0 = lds_byte(wr * 64 + fr, fq * 8), boff0 = lds_byte(wc * 32 + fr, fq * 8);
#define PG8_SA(b, h) (((b) * 2 + (h)) * HTB)
#define PG8_SB(b, h) ((4 + (b) * 2 + (h)) * HTB)
#define PG8_STAGE4(bufoff, gbase, voff, pst) do { _Pragma("unroll") for (int _i = 0; _i < 2; ++_i) \
        __builtin_amdgcn_global_load_lds((const unsigned*)((const char*)(gbase) + _i * (pst) + (voff)), (PG8_LAS unsigned*)(lds + (bufoff) + ldsw + _i * 8192), 16, 0, 0); } while (0)
#define PG8_LDA(dst, b, h) do { int a1_ = aoff0 ^ 64; asm volatile("" : "+v"(a1_)); _Pragma("unroll") for (int m = 0; m < 4; ++m) _Pragma("unroll") for (int k = 0; k < 2; ++k) dst[m][k] = *(const PG8_LAS bf16x8*)(lds + PG8_SA(b, h) + (k == 0 ? aoff0 : a1_) + m * 2048); } while (0)
#define PG8_LDB(dst, b, h) do { int b1_ = boff0 ^ 64; asm volatile("" : "+v"(b1_)); _Pragma("unroll") for (int n = 0; n < 2; ++n) _Pragma("unroll") for (int k = 0; k < 2; ++k) dst[n][k] = *(const PG8_LAS bf16x8*)(lds + PG8_SB(b, h) + (k == 0 ? boff0 : b1_) + n * 2048); } while (0)
#define PG8_MMA(ai, bj, At, Bt) do { __builtin_amdgcn_s_setprio(1); _Pragma("unroll") for (int m = 0; m < 4; ++m) _Pragma("unroll") for (int n = 0; n < 2; ++n) _Pragma("unroll") for (int k = 0; k < 2; ++k) \
        acc[ai][bj][m][n] = __builtin_amdgcn_mfma_f32_16x16x32_bf16(Bt[n][k], At[m][k], acc[ai][bj][m][n], 0, 0, 0); __builtin_amdgcn_s_setprio(0); } while (0)
#define PG8_WAIT_V(n) asm volatile("s_waitcnt vmcnt(" #n ")" ::: "memory")
#define PG8_WAIT_L(n) asm volatile("s_waitcnt lgkmcnt(" #n ")" ::: "memory")
#define PG8_BAR __builtin_amdgcn_s_barrier()
#define PG8_SCHED __builtin_amdgcn_sched_barrier(0)
    Unit cur, nxt; int ui = 0;
    if (!S.next(0, cur)) return;
#define PG8_HSCALE(buf, k) do { const int l_ = pg8_lane_id(); PG8_LAS const float* hp_ = (PG8_LAS const float*)(lds + STAGE_BYTES) + (buf) * 1024 + ((wid >> 2) * 64 + (l_ & 15)) * 4 + (k); \
        _Pragma("unroll") for (int a_ = 0; a_ < 2; ++a_) _Pragma("unroll") for (int m_ = 0; m_ < 4; m_ += 2) { \
            float f0_ = hp_[(128 * a_ + 16 * m_) * 4], f1_ = hp_[(128 * a_ + 16 * m_ + 16) * 4]; asm volatile("s_waitcnt lgkmcnt(0)" : "+v"(f0_), "+v"(f1_)); \
            _Pragma("unroll") for (int b_ = 0; b_ < 2; ++b_) _Pragma("unroll") for (int n_ = 0; n_ < 2; ++n_) { acc[a_][b_][m_][n_] *= f0_; acc[a_][b_][m_ + 1][n_] *= f1_; } \
            __builtin_amdgcn_sched_barrier(0); } } while (0)
#define PG8_HFETCH(dst, pm_) do { const int t_ = wid * 64 + pg8_lane_id(); if (t_ < 256) dst = *(const f32x4*)(g.hr + ((size_t)(pm_) * BM + t_) * 4); } while (0)
#define PG8_HPARK(src, buf) do { const int t_ = wid * 64 + pg8_lane_id(); if (t_ < 256) *(PG8_LAS f32x4*)((PG8_LAS float*)(lds + STAGE_BYTES) + (buf) * 1024 + t_ * 4) = src; } while (0)
    if constexpr (HORNER) { f32x4 h0 = {1.f, 1.f, 1.f, 1.f}; PG8_HFETCH(h0, cur.pm); PG8_HPARK(h0, 0); }
    f32x4 acc[2][2][4][2];
#pragma unroll
    for (int a = 0; a < 2; ++a)
#pragma unroll
        for (int b = 0; b < 2; ++b)
#pragma unroll
            for (int m = 0; m < 4; ++m)
#pragma unroll
                for (int n = 0; n < 2; ++n) acc[a][b][m][n] = (f32x4){0.f, 0.f, 0.f, 0.f};
    bf16x8 At[4][2], B0[2][2], B1[2][2];
    const char* cA = (const char*)g.A + (size_t)cur.pm * tstep; const char* cB = (const char*)g.Bt + (size_t)cur.pn * tstep;
    S.a_ready(cur);
    if constexpr (SP2) {
        PG8_STAGE4(PG8_SB(0, 0), cB, voffB, pstepB); PG8_STAGE4(PG8_SB(0, 1), cB + hstepB, voffB, pstepB); PG8_STAGE4(PG8_SA(0, 0), cA, voffA, pstepA); PG8_STAGE4(PG8_SA(0, 1), cA + hstep, voffA, pstepA);
        if (wr == 1) PG8_BAR;
        PG8_WAIT_V(2); PG8_BAR;
        PG8_STAGE4(PG8_SB(1, 0), cB + kstep, voffB, pstepB); PG8_STAGE4(PG8_SA(1, 0), cA + kstep, voffA, pstepA); PG8_STAGE4(PG8_SB(1, 1), cB + hstepB + kstep, voffB, pstepB);
        PG8_WAIT_V(6); PG8_BAR;
    } else {
        PG8_STAGE4(PG8_SB(0, 0), cB, voffB, pstepB); PG8_STAGE4(PG8_SA(0, 0), cA, voffA, pstepA); PG8_STAGE4(PG8_SB(0, 1), cB + hstepB, voffB, pstepB); PG8_STAGE4(PG8_SA(0, 1), cA + hstep, voffA, pstepA);
        if (wr == 1) PG8_BAR;
        PG8_WAIT_V(4); PG8_BAR;
        PG8_STAGE4(PG8_SB(1, 0), cB + kstep, voffB, pstepB); PG8_STAGE4(PG8_SA(1, 0), cA + kstep, voffA, pstepA); PG8_STAGE4(PG8_SB(1, 1), cB + hstepB + kstep, voffB, pstepB);
        PG8_WAIT_V(6); PG8_BAR;
    }
    for (;;) {
        const bool has_next = S.next(ui + 1, nxt);
        const char* nA = has_next ? (const char*)g.A + (size_t)nxt.pm * tstep : cA; const char* nB = has_next ? (const char*)g.Bt + (size_t)nxt.pn * tstep : cB;
        for (int tb = 0; tb < nt; tb += (HORNER ? 4 : nt)) {
        const int te = HORNER ? tb + 4 : nt;
        for (int t = tb; t < te; t += 2) {
            const bool last = (t == nt - 2);
            const char* a1 = cA + (size_t)(t + 1) * kstep;
            const char* a2 = last ? nA : cA + (size_t)(t + 2) * kstep; const char* b2 = last ? nB : cB + (size_t)(t + 2) * kstep;
            const char* a3 = a2 + kstep; const char* b3 = b2 + kstep;
            if (last && has_next) S.a_ready(nxt);
            if constexpr (SP2) {
            PG8_LDB(B0, 0, 0); PG8_LDB(B1, 0, 1); PG8_SCHED; PG8_LDA(At, 0, 0); PG8_STAGE4(PG8_SA(1, 1), a1 + hstep, voffA, pstepA);
            PG8_WAIT_V(8); PG8_WAIT_L(0); PG8_BAR; PG8_MMA(0, 0, At, B0); PG8_MMA(0, 1, At, B1); PG8_BAR; PG8_SCHED;
            PG8_LDA(At, 0, 1); PG8_STAGE4(PG8_SB(0, 0), b2, voffB, pstepB); PG8_STAGE4(PG8_SB(0, 1), b2 + hstepB, voffB, pstepB); PG8_STAGE4(PG8_SA(0, 0), a2, voffA, pstepA);
            PG8_WAIT_V(8); PG8_WAIT_L(0); PG8_BAR; PG8_MMA(1, 0, At, B0); PG8_MMA(1, 1, At, B1); PG8_BAR; PG8_SCHED;
            PG8_LDB(B0, 1, 0); PG8_LDB(B1, 1, 1); PG8_SCHED; PG8_LDA(At, 1, 0); PG8_STAGE4(PG8_SA(0, 1), a2 + hstep, voffA, pstepA);
            PG8_WAIT_V(8); PG8_WAIT_L(0); PG8_BAR; PG8_MMA(0, 0, At, B0); PG8_MMA(0, 1, At, B1); PG8_BAR; PG8_SCHED;
            PG8_LDA(At, 1, 1); PG8_STAGE4(PG8_SB(1, 0), b3, voffB, pstepB); PG8_STAGE4(PG8_SB(1, 1), b3 + hstepB, voffB, pstepB); PG8_STAGE4(PG8_SA(1, 0), a3, voffA, pstepA);
            PG8_WAIT_V(8); PG8_WAIT_L(0); PG8_BAR; PG8_MMA(1, 0, At, B0); PG8_MMA(1, 1, At, B1); PG8_BAR; PG8_SCHED;
            } else {
            PG8_LDB(B0, 0, 0); PG8_SCHED; PG8_LDA(At, 0, 0); PG8_STAGE4(PG8_SA(1, 1), a1 + hstep, voffA, pstepA);
            PG8_WAIT_L(8); PG8_BAR; PG8_WAIT_L(0); PG8_MMA(0, 0, At, B0); PG8_BAR; PG8_SCHED;
            PG8_LDB(B1, 0, 1); PG8_STAGE4(PG8_SB(0, 0), b2, voffB, pstepB);
            PG8_BAR; PG8_WAIT_L(0); PG8_MMA(0, 1, At, B1); PG8_BAR;
            PG8_LDA(At, 0, 1); PG8_STAGE4(PG8_SA(0, 0), a2, voffA, pstepA);
            PG8_BAR; PG8_WAIT_L(0); PG8_MMA(1, 0, At, B0); PG8_BAR; PG8_SCHED;
            PG8_STAGE4(PG8_SB(0, 1), b2 + hstepB, voffB, pstepB);
            PG8_WAIT_V(6); PG8_BAR; PG8_MMA(1, 1, At, B1); PG8_BAR;
            PG8_LDB(B0, 1, 0); PG8_SCHED; PG8_LDA(At, 1, 0); PG8_STAGE4(PG8_SA(0, 1), a2 + hstep, voffA, pstepA);
            PG8_WAIT_L(8); PG8_BAR; PG8_WAIT_L(0); PG8_MMA(0, 0, At, B0); PG8_BAR; PG8_SCHED;
            PG8_LDB(B1, 1, 1); PG8_STAGE4(PG8_SB(1, 0), b3, voffB, pstepB);
            PG8_BAR; PG8_WAIT_L(0); PG8_MMA(0, 1, At, B1); PG8_BAR;
            PG8_LDA(At, 1, 1); PG8_STAGE4(PG8_SA(1, 0), a3, voffA, pstepA);
            PG8_BAR; PG8_WAIT_L(0); PG8_MMA(1, 0, At, B0); PG8_BAR; PG8_SCHED;
            PG8_STAGE4(PG8_SB(1, 1), b3 + hstepB, voffB, pstepB);
            PG8_WAIT_V(6); PG8_BAR; PG8_MMA(1, 1, At, B1); PG8_BAR;
            }
        }
        if constexpr (HORNER) PG8_HSCALE(ui & 1, tb >> 2);
        }
        if constexpr (HORNER) {
            f32x4 hn = {1.f, 1.f, 1.f, 1.f};
            if (has_next) { PG8_HFETCH(hn, nxt.pm); PG8_HPARK(hn, (ui + 1) & 1); }
        }
        if constexpr (ALIGN_EPI) { if (wr == 0) PG8_BAR; }
        if constexpr (!Epi::AFTER_DRAIN) { E(acc, cur, wr, wc, fr, fq); S.done(cur); }
        if (!has_next) break;
#pragma unroll
        for (int a = 0; a < 2; ++a)
#pragma unroll
            for (int b = 0; b < 2; ++b)
#pragma unroll
                for (int m = 0; m < 4; ++m)
#pragma unroll
                    for (int n = 0; n < 2; ++n) acc[a][b][m][n] = (f32x4){0.f, 0.f, 0.f, 0.f};
        cur = nxt; cA = nA; cB = nB; ++ui;
        if constexpr (ALIGN_EPI) { if (wr == 1) PG8_BAR; }
    }
    PG8_WAIT_V(0);
    if constexpr (!ALIGN_EPI) { if (wr == 0) PG8_BAR; }
    PG8_BAR;
    if constexpr (Epi::AFTER_DRAIN) { E.fused(acc, cur, wr, wc, fr, fq, lds, wid, lane); S.done(cur); }
#undef PG8_SA
#undef PG8_SB
#undef PG8_STAGE4
#undef PG8_LDA
#undef PG8_LDB
#undef PG8_MMA
#undef PG8_WAIT_V
#undef PG8_WAIT_L
#undef PG8_BAR
#undef PG8_SCHED
}
}
#define GAS __attribute__((address_space(1)))
#define LAS __attribute__((address_space(3)))
typedef unsigned short bf16;
typedef unsigned v4u __attribute__((ext_vector_type(4)));
typedef float f32x4 __attribute__((ext_vector_type(4)));
typedef short bf16x8 __attribute__((ext_vector_type(8)));
typedef GAS unsigned gu32;
typedef GAS unsigned long long gu64;
#define RLX_AGENT __ATOMIC_RELAXED, __HIP_MEMORY_SCOPE_AGENT
#define LDS_WAIT() asm volatile("s_waitcnt lgkmcnt(0)" ::: "memory")
#define VM_WAIT() asm volatile("s_waitcnt vmcnt(0)" ::: "memory")
__device__ __forceinline__ unsigned long long rt() { return __builtin_amdgcn_s_memrealtime(); }
__device__ __forceinline__ unsigned f2bf(float f) { unsigned u = __builtin_bit_cast(unsigned, f); return (u + 0x7fffu + ((u >> 16) & 1u)) >> 16; }
__device__ __forceinline__ unsigned pk2(float lo, float hi) { return f2bf(lo) | (f2bf(hi) << 16); }
__device__ __forceinline__ int lane_id() { int l; asm volatile("v_mbcnt_lo_u32_b32 %0, -1, 0\n\tv_mbcnt_hi_u32_b32 %0, -1, %0" : "=v"(l)); return l; }
#define XB_TMO      128
#define XB_XCNT(j)  (256  + 64 * (j))
#define XB_XSUB(j)  (1280 + 64 * (j))
#define XB_XGEN(j)  (2304 + 64 * (j))
#define XB_TOP      3328
#define XB_TOPGEN   3392
#define XCD_BAR_WORDS 3456
#define XB_SPIN_CAP (1u << 18)

__device__ __forceinline__ unsigned xb_ld(unsigned* p)              { return __hip_atomic_load(p, __ATOMIC_RELAXED, __HIP_MEMORY_SCOPE_AGENT); }
__device__ __forceinline__ unsigned xb_add(unsigned* p, unsigned v) { return __hip_atomic_fetch_add(p, v, __ATOMIC_RELAXED, __HIP_MEMORY_SCOPE_AGENT); }
__device__ __forceinline__ unsigned xb_xcc_id() { return (unsigned)__builtin_amdgcn_s_getreg((3 << 11) | 20) & 0xFu; }
#define XB_SPIN(cond, bar) do { unsigned _sp = 0; while (cond) { __builtin_amdgcn_s_sleep(1); \
    if ((++_sp & 255u) == 0u) { if (xb_ld(&(bar)[XB_TMO])) break; if (_sp > XB_SPIN_CAP) { atomicAdd(&(bar)[XB_TMO], 1u); break; } } } } while (0)

struct XcdBarrier {
    int wave;
    unsigned* bar; unsigned x;
    volatile LAS unsigned* st;
};

__device__ __forceinline__ XcdBarrier xcd_barrier_post(unsigned* bar, volatile LAS unsigned* st, int wave) {
    XcdBarrier b; b.wave = wave; b.bar = bar; b.x = xb_xcc_id(); b.st = st;
    if (wave == 0 && lane_id() == 0) (void)xb_add(&bar[XB_XCNT(b.x)], 1u);
    return b;
}
__device__ __forceinline__ void xcd_barrier_complete(unsigned* bar, unsigned x, unsigned& nloc, unsigned& nx) {
    const unsigned G = gridDim.x * gridDim.y * gridDim.z;
    unsigned sum, cnt, mine, sp = 0u;
    for (;;) {
        sum = 0u; cnt = 0u; mine = 0u;
#pragma unroll
        for (unsigned j = 0; j < 16; ++j) { const unsigned c = xb_ld(&bar[XB_XCNT(j)]); sum += c; cnt += (c > 0u) ? 1u : 0u; mine = (j == x) ? c : mine; }
        if (sum == G) break;
        __builtin_amdgcn_s_sleep(1);
        if ((++sp & 255u) == 0u) { if (xb_ld(&bar[XB_TMO])) break; if (sp > XB_SPIN_CAP) { atomicAdd(&bar[XB_TMO], 1u); break; } }
    }
    nloc = mine > 0u ? mine : 1u; nx = cnt > 0u ? cnt : 1u;
}

__device__ __forceinline__ void xcd_barrier(const XcdBarrier& b) {
    asm volatile("s_waitcnt vmcnt(0)" ::: "memory");
    __syncthreads();
    if (b.wave == 0 && lane_id() == 0) {
        unsigned* bar = b.bar;
        __builtin_amdgcn_s_waitcnt(0);
        unsigned nloc = b.st[0], nx = b.st[1];
        if (nloc == 0u) { xcd_barrier_complete(bar, b.x, nloc, nx); b.st[0] = nloc; b.st[1] = nx; }
        const unsigned old = xb_add(&bar[XB_XSUB(b.x)], 1u);
        const unsigned gen = old / nloc;
        if (old + 1u == (gen + 1u) * nloc) {
            __builtin_amdgcn_fence(__ATOMIC_RELEASE, "agent");
            asm volatile("s_waitcnt vmcnt(0)" ::: "memory");
            const unsigned og = xb_add(&bar[XB_TOP], 1u);
            const unsigned tg = og / nx;
            if (og + 1u == (tg + 1u) * nx) xb_add(&bar[XB_TOPGEN], 1u);
            else XB_SPIN(xb_ld(&bar[XB_TOPGEN]) == tg, bar);
            __builtin_amdgcn_fence(__ATOMIC_ACQUIRE, "agent");
            xb_add(&bar[XB_XGEN(b.x)], 1u);
            asm volatile("s_waitcnt vmcnt(0)" ::: "memory");
        } else {
            XB_SPIN(xb_ld(&bar[XB_XGEN(b.x)]) == gen, bar);
            __builtin_amdgcn_fence(__ATOMIC_ACQUIRE, "agent");
            asm volatile("s_waitcnt vmcnt(0)" ::: "memory");
        }
    }
    __syncthreads();
}
constexpr int NWAVES = 8;
constexpr int BATCH = 32, SEQ = 2048, D = 1024, M = BATCH * SEQ, INW = 2816, FF = 4096, MEMLEN = 256, MROWS = BATCH * MEMLEN, XW = 256, DEPTH = 2;
constexpr float NORM_EPS = 1e-6f;
constexpr float LOG2E = 1.4426950408889634f;
constexpr float C2 = 0.125f * LOG2E;
constexpr int COL_AQ = 0, COL_AK = 256, COL_AV = 512, COL_BQ = 768, COL_BK = 1024, COL_BV = 1280, COL_CQ = 1536, COL_CK = 1792, COL_CV = 1920, COL_DQ = 2048, COL_DK = 2304, COL_DV = 2560;
constexpr int BT_STRIDE = 2112;

constexpr size_t MiB = 1u << 20;
constexpr size_t WS_CTL = 0, CTL_ZERO_BYTES = 32768;
constexpr size_t WS_BT = 1 * MiB;
constexpr size_t WS_KMEAN = 1 * MiB + 512 * 1024;
constexpr size_t WS_W = 2 * MiB, W_LAYER = 26 * MiB;
constexpr size_t WO_IN = 0, WO_OUT = WO_IN + (size_t)INW * D * 2, WO_XQ = WO_OUT + (size_t)D * D * 2, WO_XO = WO_XQ + (size_t)XW * D * 2, WO_UP = WO_XO + (size_t)D * XW * 2, WO_DOWN = WO_UP + (size_t)FF * D * 2;
static_assert(WO_DOWN + (size_t)D * FF * 2 <= W_LAYER, "weights per layer");
constexpr size_t WS_WXKV = WS_W + 2 * W_LAYER;
constexpr size_t WS_SSQ = 56 * MiB;
constexpr size_t WS_MEMN = 68 * MiB;
constexpr size_t WS_KV = 84 * MiB;
constexpr size_t WS_Q2 = 100 * MiB;
constexpr size_t WS_LSE = 132 * MiB;
constexpr size_t WS_XB = 136 * MiB;
constexpr size_t WS_PROJ = 264 * MiB;
constexpr size_t WS_Y = 616 * MiB;
constexpr size_t WS_YA1 = 744 * MiB, WS_YA2 = 776 * MiB;
constexpr size_t WS_H = 264 * MiB;
constexpr size_t WS_O2 = 808 * MiB;
constexpr size_t WS_SSQY = 840 * MiB;
constexpr size_t WS_RAT = 844 * MiB;
constexpr size_t WS_END = 848 * MiB;
static_assert(WS_PROJ + (size_t)M * INW * 2 <= WS_Y && WS_H + (size_t)M * FF * 2 <= WS_END && WS_XB + (size_t)M * D * 2 <= WS_PROJ, "d_ws map");
constexpr int CW_TMO = 0, CW_CODE = 1, CW_BAR = 4096;

constexpr int RING_OFF = 0, RING_BYTES = 131072;
constexpr int LDSCTL_OFF = 143360, MISC_OFF = LDSCTL_OFF + 320;
constexpr int LDS_BYTES = 147456;
__device__ __forceinline__ float wave_sum(float v) {
#pragma unroll
    for (int o = 1; o < 64; o <<= 1) v += __shfl_xor(v, o);
    return v;
}
__device__ __forceinline__ float bf_lo(unsigned u) { return __builtin_bit_cast(float, u << 16); }
__device__ __forceinline__ float bf_hi(unsigned u) { return __builtin_bit_cast(float, u & 0xffff0000u); }
__device__ __forceinline__ float ex2(float x) { return __builtin_amdgcn_exp2f(x); }
__device__ __forceinline__ float lg2(float x) { return __builtin_amdgcn_logf(x); }

__device__ __forceinline__ int rel_bucket(int n) {
    if (n < 16) return n;
    int b = 16;
    b += (n >= 22); b += (n >= 30); b += (n >= 40); b += (n >= 54); b += (n >= 73); b += (n >= 99); b += (n >= 134); b += (n >= 182);
    b += (n >= 246); b += (n >= 332); b += (n >= 450); b += (n >= 609); b += (n >= 825); b += (n >= 1117); b += (n >= 1513);
    return b;
}

__device__ __forceinline__ void p0_transpose_item(const float* W, int K, int N, bf16* WT, const float* g, unsigned qmask, LAS float* scr, int item, int lane) {
    const int nblk = N / 32, kb = item / nblk, nb = item % nblk, k0 = 64 * kb, n0 = 32 * nb;
    const float cs = ((qmask >> (n0 >> 8)) & 1u) ? C2 : 1.0f;
    float wv[32], gv[32];
#pragma unroll
    for (int i = 0; i < 32; ++i) { const int kk = 2 * i + (lane >> 5); wv[i] = W[(size_t)(k0 + kk) * N + n0 + (lane & 31)]; gv[i] = g ? g[k0 + kk] : 1.0f; }
#pragma unroll
    for (int i = 0; i < 32; ++i) { const int kk = 2 * i + (lane >> 5); scr[kk * 33 + (lane & 31)] = wv[i] * (gv[i] * cs); }
    LDS_WAIT(); asm volatile("" ::: "memory");
    const int c = lane & 7;
#pragma unroll
    for (int j = 0; j < 4; ++j) { const int n = (lane >> 3) + 8 * j; const LAS float* s = scr + (8 * c) * 33 + n;
        v4u o; o.x = pk2(s[0 * 33], s[1 * 33]); o.y = pk2(s[2 * 33], s[3 * 33]); o.z = pk2(s[4 * 33], s[5 * 33]); o.w = pk2(s[6 * 33], s[7 * 33]);
        *(v4u*)(WT + (size_t)(n0 + n) * K + k0 + 8 * c) = o; }
    LDS_WAIT(); asm volatile("" ::: "memory");
}

#define FLANE lane_id()
#define FTID (F.wave * 64 + lane_id())
struct Frame {
    LAS unsigned char* lds; char* ldsg;
    volatile LAS unsigned* MISC;
    gu32* ctl;
    int wave, G;
    const float* const* in;
    float* out;
    unsigned char* ws;
};
#define IN_X 0
#define IN_MEM 1
#define IN_REL 2
#define IN_GMIX 3
#define IN_WIN 4
#define IN_GGRP 5
#define IN_SINK 6
#define IN_WOUT 7
#define IN_GCROSS 8
#define IN_GMEM 9
#define IN_WXQ 10
#define IN_WXKV 11
#define IN_WXO 12
#define IN_GMLP 13
#define IN_WUP 14
#define IN_WDOWN 15
#define IN_GFINAL 16

__device__ __forceinline__ void p0_prologue(Frame& F) {
    LAS float* scr = (LAS float*)(F.lds + RING_OFF + F.wave * 16384);
    const int gw = (int)blockIdx.x * NWAVES + F.wave, NGW = F.G * NWAVES;
    constexpr int I_IN = (D / 64) * (INW / 32), I_OUT = (D / 64) * (D / 32), I_XQ = (D / 64) * (XW / 32), I_XKV = (D / 64) * (512 / 32), I_XO = (XW / 64) * (D / 32), I_UP = (D / 64) * (FF / 32), I_DOWN = (FF / 64) * (D / 32);
    constexpr int I_LAYER = I_IN + I_OUT + I_XQ + I_XKV + I_XO + I_UP + I_DOWN;
    {
        bf16* XB = (bf16*)(F.ws + WS_XB); float* ssq = (float*)(F.ws + WS_SSQ);
        constexpr int RB = 4;
        for (int k = 0; ; ++k) {
            const int m0 = gw + k * RB * NGW, it = gw + k * NGW;
            const bool hx = m0 < M, hw = it < DEPTH * I_LAYER;
            if (!hx && !hw) break;
            f32x4 v[RB][4];
            if (hx) {
#pragma unroll
                for (int r = 0; r < RB; ++r) { const f32x4* xr = (const f32x4*)(F.in[IN_X] + (size_t)(m0 + r * NGW) * D) + FLANE;
#pragma unroll
                    for (int j = 0; j < 4; ++j) v[r][j] = xr[64 * j]; }
            }
            if (hw) {
                const int l = it / I_LAYER; int r = it % I_LAYER;
                unsigned char* wl = F.ws + WS_W + (size_t)l * W_LAYER;
                const float* W; int K, N; bf16* WT; const float* g; unsigned qm = 0u;
                if (r < I_IN) { W = F.in[IN_WIN] + (size_t)l * D * INW; K = D; N = INW; WT = (bf16*)(wl + WO_IN); g = F.in[IN_GMIX] + l * D; qm = (1u << 0) | (1u << 3) | (1u << 6) | (1u << 8); }
                else if ((r -= I_IN) < I_OUT) { W = F.in[IN_WOUT] + (size_t)l * D * D; K = D; N = D; WT = (bf16*)(wl + WO_OUT); g = F.in[IN_GGRP] + l * D; }
                else if ((r -= I_OUT) < I_XQ) { W = F.in[IN_WXQ] + (size_t)l * D * XW; K = D; N = XW; WT = (bf16*)(wl + WO_XQ); g = F.in[IN_GCROSS] + l * D; qm = 1u; }
                else if ((r -= I_XQ) < I_XKV) { W = F.in[IN_WXKV] + (size_t)l * D * 512; K = D; N = 512; WT = (bf16*)(F.ws + WS_WXKV) + (size_t)l * 512 * D; g = F.in[IN_GMEM] + l * D; }
                else if ((r -= I_XKV) < I_XO) { W = F.in[IN_WXO] + (size_t)l * XW * D; K = XW; N = D; WT = (bf16*)(wl + WO_XO); g = nullptr; }
                else if ((r -= I_XO) < I_UP) { W = F.in[IN_WUP] + (size_t)l * D * FF; K = D; N = FF; WT = (bf16*)(wl + WO_UP); g = F.in[IN_GMLP] + l * D; }
                else { r -= I_UP; W = F.in[IN_WDOWN] + (size_t)l * FF * D; K = FF; N = D; WT = (bf16*)(wl + WO_DOWN); g = nullptr; }
                p0_transpose_item(W, K, N, WT, g, qm, scr, r, FLANE);
            }
            if (hx) {
#pragma unroll
                for (int r = 0; r < RB; ++r) { const int m = m0 + r * NGW; float s = 0.f;
#pragma unroll
                    for (int j = 0; j < 4; ++j) s += (v[r][j].x * v[r][j].x + v[r][j].y * v[r][j].y) + (v[r][j].z * v[r][j].z + v[r][j].w * v[r][j].w);
                    s = wave_sum(s);
                    unsigned long long* o8 = (unsigned long long*)(XB + (size_t)m * D) + FLANE;
#pragma unroll
                    for (int j = 0; j < 4; ++j) o8[64 * j] = (unsigned long long)pk2(v[r][j].x, v[r][j].y) | ((unsigned long long)pk2(v[r][j].z, v[r][j].w) << 32);
                    if (FLANE < 16) ssq[(size_t)m * 16 + FLANE] = (FLANE == 0) ? s : 0.f; }
            }
        }
    }
    {
        bf16* MN = (bf16*)(F.ws + WS_MEMN);
        for (int m = gw; m < MROWS; m += NGW) {
            const f32x4* xr = (const f32x4*)(F.in[IN_MEM] + (size_t)m * D) + FLANE;
            f32x4 v[4]; float s = 0.f;
#pragma unroll
            for (int j = 0; j < 4; ++j) { v[j] = xr[64 * j]; s += (v[j].x * v[j].x + v[j].y * v[j].y) + (v[j].z * v[j].z + v[j].w * v[j].w); }
            const float rs = 1.0f / sqrtf(wave_sum(s) * (1.0f / D) + NORM_EPS);
            unsigned long long* o8 = (unsigned long long*)(MN + (size_t)m * D) + FLANE;
#pragma unroll
            for (int j = 0; j < 4; ++j) o8[64 * j] = (unsigned long long)pk2(v[j].x * rs, v[j].y * rs) | ((unsigned long long)pk2(v[j].z * rs, v[j].w * rs) << 32);
        }
    }
    {
        float* bt = (float*)(F.ws + WS_BT);
        for (int i = (int)blockIdx.x * (NWAVES * 64) + FTID; i < 12 * 2049; i += F.G * NWAVES * 64) {
            const int hh = i / 2049, dist = i % 2049;
            bt[hh * BT_STRIDE + dist] = F.in[IN_REL][rel_bucket(dist) * 12 + hh] * LOG2E;
        }
    }
}
namespace att {
using bf16x8 = __attribute__((ext_vector_type(8))) short;
using s16x4 = __attribute__((ext_vector_type(4))) short;
using f32x16 = __attribute__((ext_vector_type(16))) float;
using u32x4 = __attribute__((ext_vector_type(4))) unsigned;
typedef short v4i16_t __attribute__((ext_vector_type(4)));
typedef float f32x2_t __attribute__((ext_vector_type(2))); typedef __bf16 bf16x2_t __attribute__((ext_vector_type(2)));
typedef __attribute__((address_space(3))) const char* lds_cptr;
constexpr int SLOTB = 8192, NSLOT = 4, NSLOT_RES = 6;
constexpr int L_K = 0, L_V = NSLOT_RES * SLOTB, L_WS = 2 * NSLOT_RES * SLOTB, L_OST = L_WS + 8 * 256, L_TBS = L_OST + 8 * 4096, TB_PAD = 128, L_FLG = L_TBS + 2048, L_TBA = L_FLG + 256, L_END = L_TBA + 3 * 2048;
constexpr int L_TBD = L_TBS, L_KM = L_WS, TB_MAXLEN = 2048 + 2 * TB_PAD + 16;
static_assert(L_END <= 143360 && L_TBD + TB_MAXLEN * 4 <= 143360 && L_KM + 2048 <= L_OST && (128 + 2 * TB_PAD + 1) * 4 <= 2048, "attention LDS map");
constexpr float NEGB = -1e30f;
__device__ __forceinline__ int crow(int r, int hi) { return (r & 3) + 8 * (r >> 2) + 4 * hi; }
#define ASBAR() __builtin_amdgcn_sched_barrier(0)
__device__ __forceinline__ void glds16(const void* gsrc, unsigned lds_dst) { unsigned keep;
    asm volatile("s_mov_b32 %0, m0\n\ts_mov_b32 m0, %2\n\ts_nop 0\n\tglobal_load_lds_dwordx4 %1, off\n\ts_mov_b32 m0, %0" : "=&s"(keep) : "v"(gsrc), "s"(lds_dst) : "memory"); }
__device__ __forceinline__ unsigned cvtpk_s(float lo, float hi) { f32x2_t v = {lo, hi}; bf16x2_t b = __builtin_convertvector(v, bf16x2_t); return __builtin_bit_cast(unsigned, b); }
#define AWAIT_BAR(N) asm volatile("s_waitcnt vmcnt(" #N ") lgkmcnt(0)\n\ts_barrier" ::: "memory")
__device__ __forceinline__ float xhalf(float v) { return __shfl_xor(v, 32); }

__device__ __forceinline__ void qkt(f32x16& p0, f32x16& p1, lds_cptr Kslot, const bf16x8* qr, float c0, int r32, int hi) {
    lds_cptr kb = Kslot + hi * 1024 + r32 * 16;
#pragma unroll
    for (int r = 0; r < 16; ++r) { p0[r] = c0; p1[r] = c0; }
#pragma unroll
    for (int d0 = 0; d0 < 4; ++d0) {
        const bf16x8 b0 = *(const __attribute__((address_space(3))) bf16x8*)(kb + d0 * 2048);
        const bf16x8 b1 = *(const __attribute__((address_space(3))) bf16x8*)(kb + d0 * 2048 + 512);
        p0 = __builtin_amdgcn_mfma_f32_32x32x16_bf16(b0, qr[d0], p0, 0, 0, 0); p1 = __builtin_amdgcn_mfma_f32_32x32x16_bf16(b1, qr[d0], p1, 0, 0, 0); }
}
__device__ __forceinline__ s16x4 vtr(lds_cptr p) { return __builtin_bit_cast(s16x4, __builtin_amdgcn_ds_read_tr16_b64_v4i16((__attribute__((address_space(3))) v4i16_t*)p)); }
__device__ __forceinline__ void pv(f32x16* o, lds_cptr vp, const u32x4* pw) {
#pragma unroll
    for (int d0 = 0; d0 < 2; ++d0) {
#pragma unroll
        for (int ks = 0; ks < 4; ++ks) {
            const s16x4 lo = vtr(vp + d0 * 4096 + ks * 1024), hi = vtr(vp + d0 * 4096 + ks * 1024 + 512);
            const bf16x8 vf = (bf16x8){lo[0], lo[1], lo[2], lo[3], hi[0], hi[1], hi[2], hi[3]};
            o[d0] = __builtin_amdgcn_mfma_f32_32x32x16_bf16(__builtin_bit_cast(bf16x8, pw[ks]), vf, o[d0], 0, 0, 0); }
    }
}

__device__ __forceinline__ void kload(bf16x8* kf, lds_cptr Kslot, int r32, int hi) {
    lds_cptr kb = Kslot + r32 * 128;
    const int x = (hi << 4) ^ (((r32 >> 1) & 7) << 4);
#pragma unroll
    for (int d0 = 0; d0 < 4; ++d0) { lds_cptr p = kb + (x ^ (d0 << 5)); kf[2 * d0] = *(const __attribute__((address_space(3))) bf16x8*)(p); kf[2 * d0 + 1] = *(const __attribute__((address_space(3))) bf16x8*)(p + 4096); }
}
__device__ __forceinline__ void vload(s16x4* vlo, s16x4* vhi, lds_cptr vp, lds_cptr vq) {
#pragma unroll
    for (int i = 0; i < 8; ++i) { lds_cptr b = (i >> 2) ? vq : vp; vlo[i] = vtr(b + (i & 3) * 2048); vhi[i] = vtr(b + (i & 3) * 2048 + 1024); }
}
__device__ __forceinline__ int vbase(int lane, int hi, int dh) { const int rl = 4 * hi + ((lane & 15) >> 2); return rl * 128 + ((dh ^ ((rl >> 1) & 1)) << 6) + ((lane >> 4) & 1) * 32 + (lane & 3) * 8; }
__device__ __forceinline__ void qkt_r(f32x16& p0, f32x16& p1, const bf16x8* kf, const bf16x8* qr, float c0) {
#pragma unroll
    for (int r = 0; r < 16; ++r) { p0[r] = c0; p1[r] = c0; }
#pragma unroll
    for (int d0 = 0; d0 < 4; ++d0) { p0 = __builtin_amdgcn_mfma_f32_32x32x16_bf16(kf[2 * d0], qr[d0], p0, 0, 0, 0); p1 = __builtin_amdgcn_mfma_f32_32x32x16_bf16(kf[2 * d0 + 1], qr[d0], p1, 0, 0, 0); }
}
__device__ __forceinline__ void pv_r(f32x16* o, const s16x4* vlo, const s16x4* vhi, const u32x4* pw) {
#pragma unroll
    for (int d0 = 0; d0 < 2; ++d0)
#pragma unroll
        for (int ks = 0; ks < 4; ++ks) { const int i = d0 * 4 + ks;
            const bf16x8 vf = (bf16x8){vlo[i][0], vlo[i][1], vlo[i][2], vlo[i][3], vhi[i][0], vhi[i][1], vhi[i][2], vhi[i][3]};
            o[d0] = __builtin_amdgcn_mfma_f32_32x32x16_bf16(__builtin_bit_cast(bf16x8, pw[ks]), vf, o[d0], 0, 0, 0); }
}
__device__ __forceinline__ void pack_p(u32x4* pw, const f32x16& p0, const f32x16& p1) {
    pw[0] = (u32x4){cvtpk_s(p0[0], p0[1]), cvtpk_s(p0[2], p0[3]), cvtpk_s(p0[4], p0[5]), cvtpk_s(p0[6], p0[7])};
    pw[1] = (u32x4){cvtpk_s(p0[8], p0[9]), cvtpk_s(p0[10], p0[11]), cvtpk_s(p0[12], p0[13]), cvtpk_s(p0[14], p0[15])};
    pw[2] = (u32x4){cvtpk_s(p1[0], p1[1]), cvtpk_s(p1[2], p1[3]), cvtpk_s(p1[4], p1[5]), cvtpk_s(p1[6], p1[7])};
    pw[3] = (u32x4){cvtpk_s(p1[8], p1[9]), cvtpk_s(p1[10], p1[11]), cvtpk_s(p1[12], p1[13]), cvtpk_s(p1[14], p1[15])};
}
__device__ __forceinline__ void build_table(char* shm, int ltb, const float* gt, int dmin, int dmax, int dscale, int tid) {
    float* R = (float*)(shm + ltb); const int OFF = dmax + TB_PAD, len = dmax + 2 * TB_PAD + 1;
    for (int k = tid; k < len; k += 512) { const int dist = OFF - k; R[k] = (dist >= dmin && dist <= dmax) ? gt[dist * dscale] : NEGB; }
}
__device__ __forceinline__ void dma_tile(const bf16* krow0, const bf16* vrow0, long rs, unsigned lds0, int slot, int wid, int lane, int lk = L_K, int lv = L_V) {
    const int krow = 8 * wid + (lane >> 3), kchunk = (lane & 7) ^ ((krow >> 1) & 7);
    const bf16* ksrc = krow0 + (long)krow * rs + kchunk * 8;
    const int vrow = 8 * wid + (lane >> 3), vchunk = (lane & 7) ^ (((vrow >> 1) & 1) << 2);
    const bf16* vsrc = vrow0 + (long)vrow * rs + vchunk * 8;
    glds16(ksrc, (unsigned)__builtin_amdgcn_readfirstlane(lds0 + lk + slot * SLOTB + wid * 1024));
    glds16(vsrc, (unsigned)__builtin_amdgcn_readfirstlane(lds0 + lv + slot * SLOTB + wid * 1024));
}
template <class RowPtr, class SsqPtr> __device__ __forceinline__ void store_o(char* shm, const f32x16* o, const float* rsc  , int wid, int lane, int r32, int hi, const RowPtr& orow, const SsqPtr& ssqp, int lost = L_OST) {
    bf16* stg = (bf16*)(shm + lost) + wid * 2048;
#pragma unroll
    for (int r = 0; r < 16; ++r) { const int q = crow(r, hi);
#pragma unroll
        for (int d0 = 0; d0 < 2; ++d0) stg[q * 64 + d0 * 32 + r32] = (bf16)f2bf(o[d0][r] * rsc[r]); }
    asm volatile("s_waitcnt lgkmcnt(0)" ::: "memory");
#pragma unroll
    for (int i = 0; i < 4; ++i) { const int row = i * 8 + (lane >> 3), ch = lane & 7; const u32x4 v = *(const u32x4*)(stg + row * 64 + ch * 8); *(u32x4*)(orow(row) + ch * 8) = v;
        float* sp = ssqp(row);
        if (sp) { float ss = 0.f;
#pragma unroll
            for (int e = 0; e < 4; ++e) { const float lo = __builtin_bit_cast(float, v[e] << 16), hf = __builtin_bit_cast(float, v[e] & 0xffff0000u); ss += lo * lo + hf * hf; }
            ss += __shfl_xor(ss, 1); ss += __shfl_xor(ss, 2); ss += __shfl_xor(ss, 4);
            if (ch == 0) *sp = ss; } }
}

template <class Pol> __device__ __forceinline__ void unit_issue_kv(const Pol& P, unsigned lds0, int wid, int lane) {
    const int NT = P.ntiles(), T0 = P.first_tile(); const long rs = P.rs();
    if (Pol::RES) {
#pragma nounroll
        for (int t = T0; t < NT; ++t) { const bf16 *kp, *vp; P.tile_ptrs(t, kp, vp); dma_tile(kp, vp, rs, lds0, t - T0, wid, lane); }
    } else if (Pol::PAIR) {
#pragma unroll
      for (int t = 0; t < 4; ++t) { const bf16 *kp, *vp; P.tile_ptrs(T0 + t, kp, vp); dma_tile(kp, vp, rs, lds0, t, wid, lane); }
    } else {
      const bf16 *kp, *vp; P.tile_ptrs(T0, kp, vp); dma_tile(kp, vp, rs, lds0, 0, wid, lane);
      if (T0 + 1 < NT) { P.tile_ptrs(T0 + 1, kp, vp); dma_tile(kp, vp, rs, lds0, 1, wid, lane); } }
}
template <class Pol> __device__ __forceinline__ void unit_issue_q(const Pol& P, unsigned lds0, int wid, int lane) {
#pragma unroll
    for (int j = 0; j < 4; ++j) { const int qrow = 8 * j + (lane >> 3), qch = (lane & 7) ^ ((qrow >> 1) & 7);
        glds16(P.q_row(wid, qrow) + qch * 8, (unsigned)__builtin_amdgcn_readfirstlane(lds0 + L_OST + wid * 4096 + j * 1024)); }
}
template <class Pol, class PolX> __device__ __forceinline__ void softmax_unit(const Pol& P, const Pol& Pn, const bool has_next, const PolX& Px, const bool has_other, const bool pre, bf16x8 (&qn)[4], char* shm, int& tkey, const int wid) {
    const int lane = lane_id(), tid = wid * 64 + lane, r32 = lane & 31, hi = lane >> 5;
    const unsigned lds0 = (unsigned)(uintptr_t)shm;
    float* wsf = (float*)(shm + L_WS) + wid * 64;
    const lds_cptr shm3 = (lds_cptr)shm;
    const lds_cptr vp0 = shm3 + L_V + vbase(lane, hi, 0), vq0 = shm3 + L_V + vbase(lane, hi, 1);
    const int NT = P.ntiles(), T0 = P.first_tile();
    const long rs = P.rs();
    if (!pre) {
        const typename Pol::Pre pr = P.setup_load(tid);
        P.setup_commit(pr, shm, tid, tkey);
        unit_issue_kv(P, lds0, wid, lane);
        unit_issue_q(P, lds0, wid, lane);
    }
    AWAIT_BAR(0);
    bf16x8 qr[4];
    if (pre) {
#pragma unroll
        for (int d0 = 0; d0 < 4; ++d0) qr[d0] = qn[d0];
    } else { lds_cptr qb = shm3 + L_OST + wid * 4096 + r32 * 128; const int x = (hi << 4) ^ (((r32 >> 1) & 7) << 4);
#pragma unroll
      for (int d0 = 0; d0 < 4; ++d0) qr[d0] = *(const __attribute__((address_space(3))) bf16x8*)(qb + (x ^ (d0 << 5))); }
    asm volatile("s_waitcnt lgkmcnt(0)" : "+v"(qr[0]), "+v"(qr[1]), "+v"(qr[2]), "+v"(qr[3]) :: "memory");
    typename Pol::Lane LS; P.prepare(LS, shm, qr, wid, lane, r32, hi);
    float mrun = P.m_init(LS), lrun = P.l_init(LS, hi);
    f32x16 o[2]; o[0] = f32x16{}; o[1] = f32x16{};
    int slot = 0;
    const bool defer = !Pol::RES && !Pol::PAIR && wid >= 4; bool pend = false; int pslot = 0; u32x4 pwp[4];
    bf16x8 kfa[8], kfb[8]; bool havek = false;
    auto tile_body = [&](const int idx, bf16x8* kf, bf16x8* kfn) __attribute__((always_inline)) {
        if (P.uses(LS, idx, wid)) {
            f32x16 p0, p1; s16x4 vlo[8], vhi[8]; float tb0[16], tb1[16];
            if (!(Pol::RES && havek)) kload(kf, shm3 + L_K + slot * SLOTB, r32, hi);
            const bool inited = mrun > -1e29f;
            const float cref = inited ? mrun : 0.f;
            float c0 = P.rowneg(LS, idx) - cref;
            bool tbl = Pol::HAS_TABLE;
            if (Pol::HAS_TABLE) {
                float cb;
                if (P.const_bias(LS, idx, wid, (const float*)(shm + P.ltb()), cb)) { c0 += cb; tbl = false; }
                else {
                    const float* R = (const float*)(shm + P.ltb()) + (P.tb_off() - P.dist0(LS, idx, wid, r32)) + 4 * hi;
#pragma unroll
                    for (int r = 0; r < 16; ++r) { const int c = (r & 3) + 8 * (r >> 2); tb0[r] = R[c]; tb1[r] = R[c + 32]; }
                }
            }
            ASBAR();
            qkt_r(p0, p1, kf, qr, c0);
            ASBAR();
            if (!defer) vload(vlo, vhi, vp0 + slot * SLOTB, vq0 + slot * SLOTB);
            havek = false;
            if (Pol::RES) { if (idx + 1 < NT && P.uses(LS, idx + 1, wid)) { kload(kfn, shm3 + L_K + (slot + 1) * SLOTB, r32, hi); havek = true; } }
            ASBAR();
            if (tbl) {
#pragma unroll
                for (int r = 0; r < 16; ++r) { p0[r] += tb0[r]; p1[r] += tb1[r]; }
            }
            float rm = __builtin_fmaxf(p0[0], p1[0]);
#pragma unroll
            for (int r = 1; r < 16; ++r) rm = __builtin_fmaxf(__builtin_fmaxf(rm, p0[r]), p1[r]);
            rm = __builtin_fmaxf(rm, xhalf(rm));
            const bool need = (rm > 8.0f) || !inited;
            if (__any(need)) {
                const float dl = need ? rm : 0.f;
                const float mnew = cref + dl;
                const float f = need ? ex2(mrun - mnew) : 1.0f;
                mrun = need ? mnew : mrun;
#pragma unroll
                for (int r = 0; r < 16; ++r) { p0[r] -= dl; p1[r] -= dl; }
                lrun *= f;
                if (hi == 0) wsf[r32] = f;
                asm volatile("s_waitcnt lgkmcnt(0)" ::: "memory");
#pragma unroll
                for (int r = 0; r < 16; ++r) { const float fr = wsf[crow(r, hi)]; o[0][r] *= fr; o[1][r] *= fr; }
            }
            float rsum = 0.f;
#pragma unroll
            for (int r = 0; r < 16; ++r) { p0[r] = ex2(p0[r]); p1[r] = ex2(p1[r]); rsum += p0[r] + p1[r]; }
            lrun += rsum;
            u32x4 pw[4]; pack_p(pw, p0, p1);
            if (defer) { pwp[0] = pw[0]; pwp[1] = pw[1]; pwp[2] = pw[2]; pwp[3] = pw[3]; pslot = slot; pend = true; }
            else pv_r(o, vlo, vhi, pw);
        }
    };
    if (Pol::RES) {
        for (int idx = T0; idx < NT; idx += 2) {
            tile_body(idx, kfa, kfb); ++slot;
            if (idx + 1 < NT) { tile_body(idx + 1, kfb, kfa); ++slot; }
        }
    } else {
    for (int idx = T0; idx < NT; ++idx) {
        if (!Pol::RES) {
            if (Pol::PAIR) {
                if (((idx - T0) & 1) == 0) {
                    if (idx + 2 < NT) { AWAIT_BAR(4); } else { AWAIT_BAR(0); }
                    if (idx + 4 < NT) { const bf16 *kp, *vp; const int s4 = slot + 4 >= 6 ? slot - 2 : slot + 4;
                                        P.tile_ptrs(idx + 4, kp, vp); dma_tile(kp, vp, rs, lds0, s4, wid, lane);
                                        P.tile_ptrs(idx + 5, kp, vp); dma_tile(kp, vp, rs, lds0, s4 + 1, wid, lane); }
                }
            } else {
                if (idx + 1 < NT) { AWAIT_BAR(2); } else { AWAIT_BAR(0); }
                if (idx + 2 < NT) { const bf16 *kp, *vp; P.tile_ptrs(idx + 2, kp, vp); dma_tile(kp, vp, rs, lds0, (slot + 2) & 3, wid, lane); }
            }
        }
        if (pend) { s16x4 vlo[8], vhi[8]; vload(vlo, vhi, vp0 + pslot * SLOTB, vq0 + pslot * SLOTB); pv_r(o, vlo, vhi, pwp); pend = false; }
        tile_body(idx, kfa, kfb);
        slot = Pol::PAIR ? (slot + 1 == 6 ? 0 : slot + 1) : ((slot + 1) & 3);
    }
    }
    if (pend) { s16x4 vlo[8], vhi[8]; vload(vlo, vhi, vp0 + pslot * SLOTB, vq0 + pslot * SLOTB); pv_r(o, vlo, vhi, pwp); }
    lrun += xhalf(lrun);
    P.finish(LS, mrun, lrun, wid, r32, hi);
    if (hi == 0) wsf[32 + r32] = 1.0f / lrun;
    asm volatile("s_waitcnt lgkmcnt(0)" ::: "memory");
    float rli[16];
#pragma unroll
    for (int r = 0; r < 16; ++r) rli[r] = wsf[32 + crow(r, hi)];
    if (has_next) {
#pragma unroll
        for (int d0 = 0; d0 < 4; ++d0) qn[d0] = *(const bf16x8*)(Pn.q_row(wid, r32) + d0 * 16 + hi * 8);
        const typename Pol::Pre pr = Pn.setup_load(tid);
        asm volatile("s_waitcnt lgkmcnt(0)\n\ts_barrier" ::: "memory");
        Pn.setup_commit(pr, shm, tid, tkey);
        unit_issue_kv(Pn, lds0, wid, lane);
    } else if (has_other) {
#pragma unroll
        for (int d0 = 0; d0 < 4; ++d0) qn[d0] = *(const bf16x8*)(Px.q_row(wid, r32) + d0 * 16 + hi * 8);
        const typename PolX::Pre pr = Px.setup_load(tid);
        asm volatile("s_waitcnt lgkmcnt(0)\n\ts_barrier" ::: "memory");
        Px.setup_commit(pr, shm, tid, tkey);
        unit_issue_kv(Px, lds0, wid, lane);
    }
    store_o(shm, o, rli, wid, lane, r32, hi, [&](int row) { return P.o_row(wid, row); }, [&](int row) { return P.ssq_row(wid, row); });
    if (!has_next && !has_other) {
        asm volatile("s_waitcnt lgkmcnt(0)\n\ts_barrier" ::: "memory");
    }
}

struct LaneNone {};
struct PolD {
    static constexpr bool HAS_TABLE = true, RES = false, PAIR = true; static constexpr int LTB = L_TBD;
    struct Lane { unsigned sel, wavesel; };
    const bf16* proj; bf16* Y; const float* bt; const float* kmean; int b, h, qb;
    __device__ __forceinline__ int ntiles() const { return 4 * (qb + 1); }
    __device__ __forceinline__ int first_tile() const { return 0; }
    __device__ __forceinline__ long rs() const { return INW; }
    __device__ __forceinline__ int tb_off() const { return 2047 + TB_PAD; }
    struct Pre { float kmv; };
    __device__ __forceinline__ int ltb() const { return LTB; }
    __device__ __forceinline__ Pre setup_load(int tid) const {
        const float* kp = kmean + ((size_t)(b * 8 + (tid >> 6)) * 2) * 256 + h * 64 + (tid & 63); return Pre{(kp[0] + kp[256]) * (1.0f / 256.0f)}; }
    __device__ __forceinline__ void setup_commit(const Pre& pr, char* shm, int tid, int& tkey) const {
        if (tkey != 100 + h) { build_table(shm, LTB, bt + (8 + h) * BT_STRIDE, 0, 2047, 1, tid); tkey = 100 + h; }
        float* km = (float*)(shm + L_KM); km[tid] = pr.kmv;
    }
    __device__ __forceinline__ const bf16* q_row(int wid, int r32) const { return proj + ((size_t)b * SEQ + qb * 256 + wid * 32 + r32) * INW + COL_DQ + h * 64; }
    __device__ __forceinline__ bf16* o_row(int wid, int row) const { return Y + ((size_t)b * SEQ + qb * 256 + wid * 32 + row) * D + 768 + h * 64; }
    float* ssqy; __device__ __forceinline__ float* ssq_row(int wid, int row) const { return ssqy + ((size_t)b * SEQ + qb * 256 + wid * 32 + row) * 16 + 12 + h; }
    __device__ __forceinline__ void tile_ptrs(int idx, const bf16*& kp, const bf16*& vp) const { const bf16* r0 = proj + ((size_t)b * SEQ + idx * 64) * INW + h * 64; kp = r0 + COL_DK; vp = r0 + COL_DV; }
    __device__ __forceinline__ void prepare(Lane& L, char* shm, const bf16x8* qr, int wid, int lane, int r32, int hi) const {
        const float* km = (const float*)(shm + L_KM);
        float gate[8];
#pragma unroll
        for (int n = 0; n < 8; ++n) { float s = 0.f;
            if (n < qb) {
#pragma unroll
                for (int d0 = 0; d0 < 4; ++d0)
#pragma unroll
                    for (int e = 0; e < 8; ++e) s += __builtin_bit_cast(float, (unsigned)(unsigned short)qr[d0][e] << 16) * km[n * 64 + d0 * 16 + hi * 8 + e];
                s += xhalf(s);
            }
            gate[n] = (n < qb) ? s : -3e38f; }
        unsigned sel = 0u;
#pragma unroll
        for (int n = 0; n < 8; ++n) { int rank = 0;
#pragma unroll
            for (int n2 = 0; n2 < 8; ++n2) rank += (n2 != n) && ((gate[n2] > gate[n]) || (gate[n2] == gate[n] && n2 < n));
            if (n < qb && rank < 3) sel |= 1u << n; }
        unsigned ws = 0u;
#pragma unroll
        for (int n = 0; n < 8; ++n) ws |= (__ballot((sel >> n) & 1u) != 0ull) ? (1u << n) : 0u;
        L.sel = sel; L.wavesel = ws;
    }
    __device__ __forceinline__ bool uses(const Lane& L, int idx, int wid) const { const int blk = idx >> 2; return blk == qb ? ((idx & 3) * 64 <= wid * 32 + 31) : ((L.wavesel >> blk) & 1u); }
    __device__ __forceinline__ float rowneg(const Lane& L, int idx) const { const int blk = idx >> 2; return (blk == qb || ((L.sel >> blk) & 1u)) ? 0.f : NEGB; }
    __device__ __forceinline__ bool const_bias(const Lane&, int idx, int wid, const float* R, float& cb) const {
        const int dlo = qb * 256 + wid * 32 - idx * 64 - 63;
        const unsigned d = (unsigned)dlo;
        const bool one = (d - 332u <= 23u) | (d - 450u <= 64u) | (d - 609u <= 121u) | (d - 825u <= 197u) | (d - 1117u <= 301u) | (dlo >= 1513);
        if ((idx >> 2) >= qb || dlo < 16 || !one) return false;
        cb = R[tb_off() - dlo]; return true; }
    __device__ __forceinline__ int dist0(const Lane&, int idx, int wid, int r32) const { return qb * 256 + wid * 32 + r32 - idx * 64; }
    __device__ __forceinline__ float m_init(const Lane&) const { return NEGB; }
    __device__ __forceinline__ float l_init(const Lane&, int) const { return 0.f; }
    __device__ __forceinline__ void finish(const Lane&, float, float, int, int, int) const {}
};

struct PolX {
    static constexpr bool HAS_TABLE = false, RES = true, PAIR = false; static constexpr int LTB = L_TBS;
    struct Lane {};
    const bf16* Q2; bf16* O2; const bf16* KV; int l, b, h, s;
    __device__ __forceinline__ int ntiles() const { return 4; }
    __device__ __forceinline__ int first_tile() const { return 0; }
    __device__ __forceinline__ long rs() const { return 1024; }
    __device__ __forceinline__ int tb_off() const { return 0; }
    struct Pre {}; __device__ __forceinline__ int ltb() const { return LTB; }
    __device__ __forceinline__ Pre setup_load(int) const { return Pre{}; }
    __device__ __forceinline__ void setup_commit(const Pre&, char*, int, int&) const {}
    __device__ __forceinline__ const bf16* q_row(int wid, int r32) const { return Q2 + ((size_t)b * SEQ + s * 256 + wid * 32 + r32) * XW + h * 64; }
    __device__ __forceinline__ bf16* o_row(int wid, int row) const { return O2 + ((size_t)b * SEQ + s * 256 + wid * 32 + row) * XW + h * 64; }
    __device__ __forceinline__ float* ssq_row(int, int) const { return nullptr; }
    __device__ __forceinline__ void tile_ptrs(int idx, const bf16*& kp, const bf16*& vp) const { kp = KV + ((size_t)b * MEMLEN + idx * 64) * 1024 + l * 512 + h * 64; vp = kp + 256; }
    __device__ __forceinline__ void prepare(Lane&, char*, const bf16x8*, int, int, int, int) const {}
    __device__ __forceinline__ bool uses(const Lane&, int, int) const { return true; }
    __device__ __forceinline__ float rowneg(const Lane&, int) const { return 0.f; }
    __device__ __forceinline__ bool const_bias(const Lane&, int, int, const float*, float&) const { return false; }
    __device__ __forceinline__ int dist0(const Lane&, int, int, int) const { return 0; }
    __device__ __forceinline__ float m_init(const Lane&) const { return NEGB; }
    __device__ __forceinline__ float l_init(const Lane&, int) const { return 0.f; }
    __device__ __forceinline__ void finish(const Lane&, float, float, int, int, int) const {}
};
struct PolC {
    static constexpr bool HAS_TABLE = true, RES = true, PAIR = false; static constexpr int LTB = L_TBS;
    struct Lane {};
    const bf16* proj; bf16* Y; const float* bt; float sink2; int b, h, s;
    __device__ __forceinline__ int ntiles() const { return 6; }
    __device__ __forceinline__ int first_tile() const { return s == 0 ? 2 : 0; }
    __device__ __forceinline__ long rs() const { return INW; }
    __device__ __forceinline__ int tb_off() const { return 127 + TB_PAD; }
    struct Pre {}; __device__ __forceinline__ int ltb() const { return LTB; }
    __device__ __forceinline__ Pre setup_load(int) const { return Pre{}; }
    __device__ __forceinline__ void setup_commit(const Pre&, char* shm, int tid, int& tkey) const { if (tkey != 300 + h) { build_table(shm, LTB, bt + (4 + h) * BT_STRIDE, 0, 127, 1, tid); tkey = 300 + h; } }
    __device__ __forceinline__ const bf16* q_row(int wid, int r32) const { return proj + ((size_t)b * SEQ + s * 256 + wid * 32 + r32) * INW + COL_CQ + h * 64; }
    __device__ __forceinline__ bf16* o_row(int wid, int row) const { return Y + ((size_t)b * SEQ + s * 256 + wid * 32 + row) * D + 512 + h * 64; }
    float* ssqy; __device__ __forceinline__ float* ssq_row(int wid, int row) const { return ssqy + ((size_t)b * SEQ + s * 256 + wid * 32 + row) * 16 + 8 + h; }
    __device__ __forceinline__ void tile_ptrs(int idx, const bf16*& kp, const bf16*& vp) const { const bf16* r0 = proj + ((size_t)b * SEQ + s * 256 - 128 + idx * 64) * INW + (h >> 1) * 64; kp = r0 + COL_CK; vp = r0 + COL_CV; }
    __device__ __forceinline__ void prepare(Lane&, char*, const bf16x8*, int, int, int, int) const {}
    __device__ __forceinline__ bool uses(const Lane&, int idx, int wid) const { const int iw = 128 + 32 * wid, j0 = 64 * idx; return j0 <= iw + 31 && j0 + 63 >= iw - 127; }
    __device__ __forceinline__ float rowneg(const Lane&, int) const { return 0.f; }
    __device__ __forceinline__ bool const_bias(const Lane&, int, int, const float*, float&) const { return false; }
    __device__ __forceinline__ int dist0(const Lane&, int idx, int wid, int r32) const { return 128 + 32 * wid + r32 - 64 * idx; }
    __device__ __forceinline__ float m_init(const Lane&) const { return sink2; }
    __device__ __forceinline__ float l_init(const Lane&, int hi) const { return hi == 0 ? 1.0f : 0.f; }
    __device__ __forceinline__ void finish(const Lane&, float, float, int, int, int) const {}
};
struct PolA {
    static constexpr bool HAS_TABLE = true, RES = true, PAIR = false; static constexpr int LTB = L_TBS;
    struct Lane {};
    const bf16* proj; bf16* Y; bf16* YA1; bf16* YA2; float* lse; const float* bt; int b, h, cfg, sub;
    __device__ __forceinline__ int dil() const { return cfg == 0 ? 1 : (cfg == 1 ? 4 : 16); }
    __device__ __forceinline__ int ntiles() const { return cfg == 2 ? 4 : 6; }
    __device__ __forceinline__ int first_tile() const { return cfg == 2 ? 0 : (((cfg == 0 ? sub : (sub & 1)) == 0) ? 2 : 0); }
    __device__ __forceinline__ long rs() const { return (long)dil() * INW; }
    __device__ __forceinline__ int tb_off() const { return 128 + TB_PAD; }
    struct Pre {}; __device__ __forceinline__ int ltb() const { return L_TBA + cfg * 2048; }
    __device__ __forceinline__ Pre setup_load(int) const { return Pre{}; }
    __device__ __forceinline__ void setup_commit(const Pre&, char* shm, int tid, int& tkey) const {
        if (tkey != 200 + h) { build_table(shm, L_TBA, bt + h * BT_STRIDE, 0, 128, 1, tid); build_table(shm, L_TBA + 2048, bt + h * BT_STRIDE, 0, 128, 4, tid);
                               build_table(shm, L_TBA + 4096, bt + h * BT_STRIDE, 0, 128, 16, tid); tkey = 200 + h; } }
    __device__ __forceinline__ int token(int wid, int r) const {
        if (cfg == 0) return sub * 256 + wid * 32 + r;
        if (cfg == 1) return (sub >> 1) + 4 * ((sub & 1) * 256 + wid * 32 + r);
        return (2 * sub + (wid >> 2)) + 16 * ((wid & 3) * 32 + r);
    }
    __device__ __forceinline__ const bf16* q_row(int wid, int r32) const { return proj + ((size_t)b * SEQ + token(wid, r32)) * INW + COL_AQ + h * 64; }
    __device__ __forceinline__ bf16* o_row(int wid, int row) const { const size_t t = (size_t)b * SEQ + token(wid, row);
        return cfg == 0 ? Y + t * D + h * 64 : (cfg == 1 ? YA1 : YA2) + t * 256 + h * 64; }
    __device__ __forceinline__ float* ssq_row(int, int) const { return nullptr; }
    __device__ __forceinline__ void tile_ptrs(int idx, const bf16*& kp, const bf16*& vp) const {
        int t0;
        if (cfg == 0) t0 = sub * 256 - 128 + idx * 64;
        else if (cfg == 1) t0 = (sub >> 1) + 4 * ((sub & 1) * 256 - 128 + idx * 64);
        else t0 = (2 * sub + (idx >> 1)) + 16 * ((idx & 1) * 64);
        const bf16* r0 = proj + ((size_t)b * SEQ + t0) * INW + h * 64; kp = r0 + COL_AK; vp = r0 + COL_AV; }
    __device__ __forceinline__ void prepare(Lane&, char*, const bf16x8*, int, int, int, int) const {}
    __device__ __forceinline__ bool uses(const Lane&, int idx, int wid) const {
        if (cfg == 2) return (idx >> 1) == (wid >> 2) && 64 * (idx & 1) <= 32 * (wid & 3) + 31;
        const int iw = 128 + 32 * wid, j0 = 64 * idx; return j0 <= iw + 31 && j0 + 63 >= iw - 128; }
    __device__ __forceinline__ float rowneg(const Lane&, int) const { return 0.f; }
    __device__ __forceinline__ bool const_bias(const Lane&, int, int, const float*, float&) const { return false; }
    __device__ __forceinline__ int dist0(const Lane&, int idx, int wid, int r32) const { return cfg == 2 ? (32 * (wid & 3) + r32 - 64 * (idx & 1)) : (128 + 32 * wid + r32 - 64 * idx); }
    __device__ __forceinline__ float m_init(const Lane&) const { return NEGB; }
    __device__ __forceinline__ float l_init(const Lane&, int) const { return 0.f; }
    __device__ __forceinline__ void finish(const Lane&, float m, float l, int wid, int r32, int hi) const {
        if (hi == 0) lse[((size_t)cfg * M + (size_t)b * SEQ + token(wid, r32)) * 4 + h] = m + lg2(l); }
};

struct PolNone {
    static constexpr bool RES = true, PAIR = false; struct Pre {};
    __device__ __forceinline__ int ntiles() const { return 0; }
    __device__ __forceinline__ int first_tile() const { return 0; }
    __device__ __forceinline__ long rs() const { return 0; }
    __device__ __forceinline__ void tile_ptrs(int, const bf16*& kp, const bf16*& vp) const { kp = nullptr; vp = nullptr; }
    __device__ __forceinline__ const bf16* q_row(int, int) const { return nullptr; }
    __device__ __forceinline__ Pre setup_load(int) const { return Pre{}; }
    __device__ __forceinline__ void setup_commit(const Pre&, char*, int, int&) const {}
};
struct PolSBNext {
    static constexpr bool RES = true, PAIR = false; struct Pre {};
    const bf16* proj; int b, h, s;
    __device__ __forceinline__ int ntiles() const { const int NT = 4 * s + 4; return NT < 6 ? NT : 6; }
    __device__ __forceinline__ int first_tile() const { return 0; }
    __device__ __forceinline__ long rs() const { return INW; }
    __device__ __forceinline__ void tile_ptrs(int k, const bf16*& kp, const bf16*& vp) const { const bf16* r0 = proj + ((size_t)b * SEQ + (size_t)(4 * s + 3 - k) * 64) * INW + h * 64; kp = r0 + COL_BK; vp = r0 + COL_BV; }
    __device__ __forceinline__ const bf16* q_row(int wid, int r32) const { return proj + ((size_t)b * SEQ + s * 256 + wid * 32 + r32) * INW + COL_BQ + h * 64; }
    __device__ __forceinline__ Pre setup_load(int) const { return Pre{}; }
    __device__ __forceinline__ void setup_commit(const Pre&, char*, int, int&) const {}
};

constexpr int SB_NR = 6, SB_LK = 0, SB_LV = SB_NR * SLOTB, SB_END = 2 * SB_NR * SLOTB;
static_assert(SB_NR == 6 && SB_LK == L_K && SB_LV == L_V, "PolSBNext requests the first unit's tiles through the resident-mode slot map");
static_assert(SB_END <= L_WS, "stick-breaking LDS map");
__device__ __forceinline__ void sb_unit(const bf16* proj, bf16* Y, float* ssqy, int b, int h, int s, int nb, int ns, const bool has_next, const bool pre, bf16x8 (&qn)[4], char* shm, const int wid) {
    const int lane = lane_id(), tid = wid * 64 + lane, r32 = lane & 31, hi = lane >> 5;
    const unsigned lds0 = (unsigned)(uintptr_t)shm;
    const lds_cptr shm3 = (lds_cptr)shm;
    const lds_cptr vp0 = shm3 + SB_LV + vbase(lane, hi, 0), vq0 = shm3 + SB_LV + vbase(lane, hi, 1);
    __attribute__((address_space(3))) unsigned* flg = (__attribute__((address_space(3))) unsigned*)(shm3 + L_FLG);
    const int NT = 4 * s + 4, NR = NT < SB_NR ? NT : SB_NR;
    const bf16* kbase = proj + (size_t)b * SEQ * INW + COL_BK + h * 64; const bf16* vbase = proj + (size_t)b * SEQ * INW + COL_BV + h * 64;
#define SB_TILE(idx) (4 * s + 3 - (idx))
#define SB_DMA(idx, slot) dma_tile(kbase + (size_t)SB_TILE(idx) * 64 * INW, vbase + (size_t)SB_TILE(idx) * 64 * INW, INW, lds0, (slot), wid, lane, SB_LK, SB_LV)
    bf16x8 qr[4];
    if (!pre) {
#pragma nounroll
        for (int k = 0; k < NR; ++k) SB_DMA(k, k);
        const bf16* Qrow = proj + ((size_t)b * SEQ + s * 256 + wid * 32 + r32) * INW + COL_BQ + h * 64;
#pragma unroll
        for (int d0 = 0; d0 < 4; ++d0) qr[d0] = *(const bf16x8*)(Qrow + d0 * 16 + hi * 8);
    } else {
#pragma unroll
        for (int d0 = 0; d0 < 4; ++d0) qr[d0] = qn[d0];
    }
    AWAIT_BAR(0);
    asm volatile("" : "+v"(qr[0]), "+v"(qr[1]), "+v"(qr[2]), "+v"(qr[3]));
    float carry = 1.0f; f32x16 o[2]; o[0] = f32x16{}; o[1] = f32x16{};
    const int iq = s * 256 + wid * 32 + r32;
    bool wdone = false;
#define SB_COMPUTE(slot_, j0_) do { \
        f32x16 p0, p1; bf16x8 kf[8]; s16x4 vlo[8], vhi[8]; \
        kload(kf, shm3 + SB_LK + (slot_) * SLOTB, r32, hi); \
        ASBAR(); \
        qkt_r(p0, p1, kf, qr, 0.f); \
        ASBAR(); \
        vload(vlo, vhi, vp0 + (slot_) * SLOTB, vq0 + (slot_) * SLOTB); \
        ASBAR(); \
        const bool diag = ((j0_) + 63 >= s * 256 + wid * 32); \
        const int dist0 = iq - (j0_) - 4 * hi; \
        if (diag) { _Pragma("unroll") for (int r = 0; r < 16; ++r) { const int c = (r & 3) + 8 * (r >> 2); if (dist0 - c < 1) p0[r] = -1e30f; if (dist0 - c - 32 < 1) p1[r] = -1e30f; } } \
          \
          \
        f32x2_t rr[16]; \
        _Pragma("unroll") for (int r = 0; r < 16; ++r) { f32x2_t w_ = (f32x2_t){ex2(p0[r]), ex2(p1[r])} + 1.0f; rr[r] = (f32x2_t){__builtin_amdgcn_rcpf(w_.x), __builtin_amdgcn_rcpf(w_.y)}; } \
        f32x2_t gsv[4], pgv[4]; \
        _Pragma("unroll") for (int g = 0; g < 4; ++g) gsv[g] = (rr[4 * g] * rr[4 * g + 1]) * (rr[4 * g + 2] * rr[4 * g + 3]); \
        _Pragma("unroll") for (int g = 0; g < 4; ++g) pgv[g] = (f32x2_t){xhalf(gsv[g].x), xhalf(gsv[g].y)}; \
          \
        float T[8]; float run = carry; \
        _Pragma("unroll") for (int g = 7; g >= 0; --g) { const float gsg = g >= 4 ? gsv[g & 3].y : gsv[g & 3].x, pgg = g >= 4 ? pgv[g & 3].y : pgv[g & 3].x; T[g] = hi == 0 ? run * pgg : run; run *= gsg * pgg; } \
          \
        f32x2_t a2[16]; \
        _Pragma("unroll") for (int g = 0; g < 4; ++g) { f32x2_t S = (f32x2_t){T[g], T[4 + g]}; \
            _Pragma("unroll") for (int i = 3; i >= 0; --i) { const f32x2_t Sn = S * rr[4 * g + i]; a2[4 * g + i] = S - Sn; S = Sn; } } \
        carry = run; \
        u32x4 pw[4]; \
        _Pragma("unroll") for (int q_ = 0; q_ < 2; ++q_) _Pragma("unroll") for (int e_ = 0; e_ < 4; ++e_) { \
            pw[q_][e_] = cvtpk_s(a2[8 * q_ + 2 * e_].x, a2[8 * q_ + 2 * e_ + 1].x); pw[2 + q_][e_] = cvtpk_s(a2[8 * q_ + 2 * e_].y, a2[8 * q_ + 2 * e_ + 1].y); } \
        pv_r(o, vlo, vhi, pw); \
        wdone = __all(carry < 0x1p-48f); \
    } while (0)
#pragma nounroll
    for (int k = 0; k < NR; ++k) {
        const int j0 = SB_TILE(k) * 64;
        if (!wdone && j0 < s * 256 + wid * 32 + 31) SB_COMPUTE(k, j0);
    }
    if (NT > NR) {
        if (lane == 0) flg[16 + wid] = wdone ? 1u : 0u;
        asm volatile("s_waitcnt lgkmcnt(0)\n\ts_barrier" ::: "memory");
        const unsigned alld = flg[16] & flg[17] & flg[18] & flg[19] & flg[20] & flg[21] & flg[22] & flg[23];
        if (!__builtin_amdgcn_readfirstlane(alld)) {
            SB_DMA(NR, 0);
            if (NR + 1 < NT) SB_DMA(NR + 1, 1);
            int slot = 0;
            for (int idx = NR; idx < NT; ++idx) {
                if (idx + 1 < NT) { AWAIT_BAR(2); } else { AWAIT_BAR(0); }
                if (idx > NR) { const __attribute__((address_space(3))) unsigned* f = flg + ((idx - 1) & 1) * 8; unsigned all = f[0] & f[1] & f[2] & f[3] & f[4] & f[5] & f[6] & f[7]; if (__builtin_amdgcn_readfirstlane(all)) break; }
                if (idx + 2 < NT) SB_DMA(idx + 2, (slot + 2) & 3);
                const int j0 = SB_TILE(idx) * 64;
                if (!wdone) SB_COMPUTE(slot, j0);
                if (lane == 0) flg[(idx & 1) * 8 + wid] = wdone ? 1u : 0u;
                slot = (slot + 1) & 3;
            }
            asm volatile("s_waitcnt vmcnt(0)" ::: "memory");
        }
    }
#undef SB_COMPUTE
#undef SB_DMA
#undef SB_TILE
    if (has_next) {
        const bf16* Qrow = proj + ((size_t)nb * SEQ + ns * 256 + wid * 32 + r32) * INW + COL_BQ + h * 64;
#pragma unroll
        for (int d0 = 0; d0 < 4; ++d0) qn[d0] = *(const bf16x8*)(Qrow + d0 * 16 + hi * 8);
    }
    asm volatile("s_waitcnt lgkmcnt(0)\n\ts_barrier" ::: "memory");
    if (has_next) {
        const int nNT = 4 * ns + 4, nNR = nNT < SB_NR ? nNT : SB_NR;
        const bf16* nk = proj + (size_t)nb * SEQ * INW + COL_BK + h * 64; const bf16* nv = proj + (size_t)nb * SEQ * INW + COL_BV + h * 64;
#pragma nounroll
        for (int k = 0; k < nNR; ++k) dma_tile(nk + (size_t)(4 * ns + 3 - k) * 64 * INW, nv + (size_t)(4 * ns + 3 - k) * 64 * INW, INW, lds0, k, wid, lane, SB_LK, SB_LV);
    }
    float one[16];
#pragma unroll
    for (int r = 0; r < 16; ++r) one[r] = 1.0f;
    store_o(shm, o, one, wid, lane, r32, hi, [&](int row) { return Y + ((size_t)b * SEQ + s * 256 + wid * 32 + row) * D + 256 + h * 64; },
            [&](int row) { return ssqy + ((size_t)b * SEQ + s * 256 + wid * 32 + row) * 16 + 4 + h; });
    if (!has_next) { asm volatile("s_waitcnt lgkmcnt(0)\n\ts_barrier" ::: "memory"); }
}
}
__device__ __forceinline__ void nm_merge(Frame& F) {
    bf16* Y = (bf16*)(F.ws + WS_Y); const bf16* YA1 = (const bf16*)(F.ws + WS_YA1); const bf16* YA2 = (const bf16*)(F.ws + WS_YA2); const float* lse = (const float*)(F.ws + WS_LSE);
    const float* ssqy = (const float*)(F.ws + WS_SSQY); float* rat = (float*)(F.ws + WS_RAT);
    const int gw = (int)blockIdx.x * NWAVES + F.wave, NGW = F.G * NWAVES;
    constexpr int RB = 4;
    for (int row0 = gw; row0 < M; row0 += RB * NGW) {
        unsigned long long w[RB], wa[RB], wc[RB]; float l0[RB], l1[RB], l2[RB], pp[RB];
#pragma unroll
        for (int j = 0; j < RB; ++j) { const int row = row0 + j * NGW;
            w[j] = *((const unsigned long long*)(Y + (size_t)row * D) + FLANE);
            const int hh = FLANE >> 4;
            l0[j] = lse[(size_t)row * 4 + hh]; l1[j] = lse[(size_t)(M + row) * 4 + hh]; l2[j] = lse[(size_t)(2 * M + row) * 4 + hh];
            wa[j] = *((const unsigned long long*)(YA1 + (size_t)row * 256) + FLANE); wc[j] = *((const unsigned long long*)(YA2 + (size_t)row * 256) + FLANE);
            pp[j] = ssqy[(size_t)row * 16 + (FLANE & 15)];
        }
#pragma unroll
        for (int j = 0; j < RB; ++j) { const int row = row0 + j * NGW;
            const unsigned long long ww = w[j];
            float v0 = bf_lo((unsigned)ww), v1 = bf_hi((unsigned)ww), v2 = bf_lo((unsigned)(ww >> 32)), v3 = bf_hi((unsigned)(ww >> 32));
            const float mx = __builtin_fmaxf(l0[j], __builtin_fmaxf(l1[j], l2[j]));
            const float w0 = ex2(l0[j] - mx), w1 = ex2(l1[j] - mx), w2 = ex2(l2[j] - mx), inv = 1.0f / (w0 + w1 + w2);
            const unsigned long long a = wa[j], c = wc[j];
            v0 = (w0 * v0 + w1 * bf_lo((unsigned)a) + w2 * bf_lo((unsigned)c)) * inv; v1 = (w0 * v1 + w1 * bf_hi((unsigned)a) + w2 * bf_hi((unsigned)c)) * inv;
            v2 = (w0 * v2 + w1 * bf_lo((unsigned)(a >> 32)) + w2 * bf_lo((unsigned)(c >> 32))) * inv; v3 = (w0 * v3 + w1 * bf_hi((unsigned)(a >> 32)) + w2 * bf_hi((unsigned)(c >> 32))) * inv;
            const unsigned p01 = pk2(v0, v1), p23 = pk2(v2, v3);
            *((unsigned long long*)(Y + (size_t)row * D) + FLANE) = (unsigned long long)p01 | ((unsigned long long)p23 << 32);
            const float r0 = bf_lo(p01), r1 = bf_hi(p01), r2 = bf_lo(p23), r3 = bf_hi(p23);
            const float ssA = wave_sum((r0 * r0 + r1 * r1) + (r2 * r2 + r3 * r3));
            float sg = pp[j]; sg += __shfl_xor(sg, 1); sg += __shfl_xor(sg, 2);
            const float ssB = __shfl(sg, 4), ssC = __shfl(sg, 8), ssD = __shfl(sg, 12);
            const float sA = 1.0f / sqrtf(ssA * (1.0f / 256.0f) + NORM_EPS), sB = 1.0f / sqrtf(ssB * (1.0f / 256.0f) + NORM_EPS);
            const float sC = 1.0f / sqrtf(ssC * (1.0f / 256.0f) + NORM_EPS), sD = 1.0f / sqrtf(ssD * (1.0f / 256.0f) + NORM_EPS);
            if (FLANE == 0) *(f32x4*)(rat + (size_t)row * 4) = f32x4{sA / sB, sB / sC, sC / sD, sD};
        }
    }
}
__device__ __forceinline__ void fn_finalnorm(Frame& F, const float* ssq) {
    const int gw = (int)blockIdx.x * NWAVES + F.wave, NGW = F.G * NWAVES;
    const f32x4* gf = (const f32x4*)F.in[IN_GFINAL] + FLANE;
    const bf16* XB = (const bf16*)(F.ws + WS_XB);
    f32x4 gv[4];
#pragma unroll
    for (int j = 0; j < 4; ++j) gv[j] = gf[64 * j];
    constexpr int RB = 4;
    for (int row0 = gw; row0 < M; row0 += RB * NGW) {
        unsigned long long w[RB][4]; float s[RB];
#pragma unroll
        for (int r = 0; r < RB; ++r) { const int row = row0 + r * NGW;
            s[r] = (FLANE < 16) ? ssq[(size_t)row * 16 + FLANE] : 0.f;
            const unsigned long long* xr = (const unsigned long long*)(XB + (size_t)row * D) + FLANE;
#pragma unroll
            for (int j = 0; j < 4; ++j) w[r][j] = xr[64 * j]; }
#pragma unroll
        for (int r = 0; r < RB; ++r) { const int row = row0 + r * NGW;
            const float rs = 1.0f / sqrtf(wave_sum(s[r]) * (1.0f / D) + NORM_EPS);
            f32x4* orow = (f32x4*)(F.out + (size_t)row * D) + FLANE;
#pragma unroll
            for (int j = 0; j < 4; ++j) { const unsigned long long ww = w[r][j];
                f32x4 v = {bf_lo((unsigned)ww), bf_hi((unsigned)ww), bf_lo((unsigned)(ww >> 32)), bf_hi((unsigned)(ww >> 32))};
                __builtin_nontemporal_store(v * rs * gv[j], orow + 64 * j); } }
    }
}
__device__ __forceinline__ void at_phase(Frame& F, int l) {
    const bf16* proj = (const bf16*)(F.ws + WS_PROJ); bf16* Y = (bf16*)(F.ws + WS_Y); const float* bt = (const float*)(F.ws + WS_BT); const float* kmean = (const float*)(F.ws + WS_KMEAN);
    const float* sinks = F.in[IN_SINK] + l * 4;
    float* ssqy = (float*)(F.ws + WS_SSQY);
    char* shm = F.ldsg + RING_OFF;
    const int G = F.G, cwg = (int)blockIdx.x, x = cwg & 7, q = cwg >> 3, gidx = q >> 3, j = q & 7;
    int tkey = -1;
    pg8::bf16x8 qn[4];
    if (G == 256) {
#pragma nounroll
    for (int i = 0; i < 4; ++i) {
        att::PolD P{proj, Y, bt, kmean, i * 8 + x, gidx, (i & 1) ? (7 - j) : j, ssqy};
        att::PolD Pn{proj, Y, bt, kmean, ((i + 1) & 3) * 8 + x, gidx, ((i + 1) & 1) ? (7 - j) : j, ssqy};
        att::PolA PA0{proj, Y, (bf16*)(F.ws + WS_YA1), (bf16*)(F.ws + WS_YA2), (float*)(F.ws + WS_LSE), bt, x, gidx, 0, j};
        att::softmax_unit(P, Pn, i + 1 < 4, PA0, i + 1 == 4, i > 0, qn, shm, tkey, F.wave);
    }
#pragma nounroll
    for (int i = 0; i < 12; ++i) {
        att::PolA P{proj, Y, (bf16*)(F.ws + WS_YA1), (bf16*)(F.ws + WS_YA2), (float*)(F.ws + WS_LSE), bt, (i / 3) * 8 + x, gidx, i % 3, j};
        const int i1 = i + 1 < 12 ? i + 1 : 0;
        att::PolA Pn{proj, Y, (bf16*)(F.ws + WS_YA1), (bf16*)(F.ws + WS_YA2), (float*)(F.ws + WS_LSE), bt, (i1 / 3) * 8 + x, gidx, i1 % 3, j};
        const int hc0 = 2 * (x & 1) + ((q >> 3) & 1);
        att::PolC PC0{proj, Y, bt, sinks[hc0] * LOG2E, (q >> 4) * 4 + (x >> 1), hc0, j, ssqy};
        att::softmax_unit(P, Pn, i + 1 < 12, PC0, i + 1 == 12, true, qn, shm, tkey, F.wave);
    }
#pragma nounroll
    for (int i = 0; i < 4; ++i) {
        const int hc = 2 * (x & 1) + ((q >> 3) & 1);
        att::PolC P{proj, Y, bt, sinks[hc] * LOG2E, i * 8 + (q >> 4) * 4 + (x >> 1), hc, j, ssqy};
        att::PolC Pn{proj, Y, bt, sinks[hc] * LOG2E, ((i + 1) & 3) * 8 + (q >> 4) * 4 + (x >> 1), hc, j, ssqy};
        att::PolSBNext PB0{proj, x, gidx, j};
        att::softmax_unit(P, Pn, i + 1 < 4, PB0, i + 1 == 4, true, qn, shm, tkey, F.wave);
    }
#pragma nounroll
    for (int i = 0; i < 4; ++i) {
        att::sb_unit(proj, Y, ssqy, i * 8 + x, gidx, j, ((i + 1) & 3) * 8 + x, j, i + 1 < 4, true, qn, shm, F.wave);
    }
    }
}
constexpr int PH_P0 = 0, PH_GKV = 1, PH_L0 = 2, PH_PER_LAYER = 10, PH_FN = PH_L0 + DEPTH * PH_PER_LAYER, NPHASE = PH_FN + 1;
#ifndef MK_SPLIT
#define MK_SPLIT 0
#endif
#define IN(k) (lo <= (k) && (k) < hi)
#define SEAM(k) do { if (IN(k) && IN((k) + 1)) xcd_barrier(bar); } while (0)
template <int l> __device__ __forceinline__ void layer_phases(Frame& F, const XcdBarrier& bar, const int lo, const int hi) {
    unsigned char* ws = F.ws;
        const int pb = PH_L0 + l * PH_PER_LAYER;
        const unsigned char* wl = ws + WS_W + (size_t)l * W_LAYER;
        float* ssqA = (float*)(ws + WS_SSQ); float* ssqB = ssqA + (size_t)M * 16; float* ssqC = ssqB + (size_t)M * 16;
        if (IN(pb + 0)) {
            pg8::Gemm g{(const bf16*)(ws + WS_XB), (const bf16*)(wl + WO_IN), M, INW, D}; pg8::StaticOrder S; S.init(M, INW, F.G, (int)blockIdx.x);
            pg8::EpiRowScale<0, true> E{(bf16*)(ws + WS_PROJ), INW, ssqA, (float*)(ws + WS_KMEAN)};
            pg8::gemm_phase<pg8::EpiRowScale<0, true>, pg8::StaticOrder, true, true>(F.lds + RING_OFF, g, S, E, F.wave);
        }
        SEAM(pb + 0);
        if (IN(pb + 2)) {
at_phase(F, l);
 }
        SEAM(pb + 2);
        if (IN(pb + 3)) { nm_merge(F); }
        SEAM(pb + 3);
        if (IN(pb + 4)) {
            pg8::Gemm g{(const bf16*)(ws + WS_Y), (const bf16*)(wl + WO_OUT), M, D, D, (const float*)(ws + WS_RAT)}; pg8::StaticOrder S; S.init(M, D, F.G, (int)blockIdx.x);
            pg8::EpiResid<true> E{(bf16*)(ws + WS_XB), ssqB};
            pg8::gemm_phase<pg8::EpiResid<true>, pg8::StaticOrder, true, true, true>(F.lds + RING_OFF, g, S, E, F.wave);
        }
        SEAM(pb + 4);
        if (IN(pb + 5)) {
            {
                pg8::StaticOrder S3; S3.init(M, XW, F.G, (int)blockIdx.x);
                pg8::Gemm g{(const bf16*)(ws + WS_XB), (const bf16*)(wl + WO_XQ), M, XW, D};
                pg8::EpiRowScale<0> E{(bf16*)(ws + WS_Q2), XW, ssqB, nullptr};
                pg8::gemm_phase<pg8::EpiRowScale<0>, pg8::StaticOrder, true, true>(F.lds + RING_OFF, g, S3, E, F.wave);
            }
            asm volatile("s_waitcnt vmcnt(0)" ::: "memory"); __syncthreads();
            if (F.G == 256) {
                pg8::StaticOrder S3; S3.init(M, XW, F.G, (int)blockIdx.x); pg8::Unit u0; S3.next(0, u0);
                char* shm = F.ldsg + RING_OFF; int tkey = -1; pg8::bf16x8 qn[4];
#pragma nounroll
                for (int hh = 0; hh < 4; ++hh) {
                    att::PolX P{(const bf16*)(ws + WS_Q2), (bf16*)(ws + WS_O2), (const bf16*)(ws + WS_KV), l, u0.pm >> 3, hh, u0.pm & 7};
                    att::PolX Pn{(const bf16*)(ws + WS_Q2), (bf16*)(ws + WS_O2), (const bf16*)(ws + WS_KV), l, u0.pm >> 3, (hh + 1) & 3, u0.pm & 7};
                    att::softmax_unit(P, Pn, hh + 1 < 4, att::PolNone{}, false, hh > 0, qn, shm, tkey, F.wave);
                }
            }
            asm volatile("s_waitcnt vmcnt(0)" ::: "memory"); __syncthreads();
            if (F.G == 256) {
                pg8::StaticOrder S3; S3.init(M, XW, F.G, (int)blockIdx.x); pg8::Unit u0; S3.next(0, u0);
                pg8::Gemm g{(const bf16*)(ws + WS_O2), (const bf16*)(wl + WO_XO), M, D, XW}; int n4 = 4; asm volatile("" : "+s"(n4));     pg8::PanelOrder S4{u0.pm, n4};
                pg8::EpiResid<false> E{(bf16*)(ws + WS_XB), ssqC};
                pg8::gemm_phase<pg8::EpiResid<false>, pg8::PanelOrder, true, true>(F.lds + RING_OFF, g, S4, E, F.wave);
            }
        }
        SEAM(pb + 5);
        if (IN(pb + 8)) {
            pg8::Gemm g{(const bf16*)(ws + WS_XB), (const bf16*)(wl + WO_UP), M, FF, D}; pg8::StaticOrder S; S.init(M, FF, F.G, (int)blockIdx.x);
            pg8::EpiRowScale<1, true> E{(bf16*)(ws + WS_H), FF, ssqC, nullptr};
            pg8::gemm_phase<pg8::EpiRowScale<1, true>, pg8::StaticOrder, true, true>(F.lds + RING_OFF, g, S, E, F.wave);
        }
        SEAM(pb + 8);
        if (IN(pb + 9)) {
            pg8::Gemm g{(const bf16*)(ws + WS_H), (const bf16*)(wl + WO_DOWN), M, D, FF}; pg8::StaticOrder S; S.init(M, D, F.G, (int)blockIdx.x);
            pg8::EpiResid<true> E{(bf16*)(ws + WS_XB), ssqA};
            pg8::gemm_phase<pg8::EpiResid<true>, pg8::StaticOrder, true, true>(F.lds + RING_OFF, g, S, E, F.wave);
        }
        SEAM(pb + 9);
}
#undef IN
#undef SEAM
struct Args { const float* in[17]; float* out; unsigned char* ws; int ph_lo, ph_hi; };
__global__ void __launch_bounds__(NWAVES * 64, 2) mk_fwd(Args args) {
    extern __shared__ __attribute__((aligned(16))) unsigned char lds[];
    Frame F;
    F.lds = (LAS unsigned char*)lds; F.ldsg = (char*)lds;
    F.MISC = (volatile LAS unsigned*)(F.lds + MISC_OFF);
    F.wave = __builtin_amdgcn_readfirstlane((int)threadIdx.x >> 6);
    F.G = gridDim.x;
    unsigned char* ws = args.ws; F.ws = ws; F.out = args.out;
    F.ctl = (gu32*)(ws + WS_CTL);
    F.in = args.in;
    for (int u = FTID; u < (LDS_BYTES - LDSCTL_OFF) / 4; u += NWAVES * 64) ((LAS unsigned*)(F.lds + LDSCTL_OFF))[u] = 0u;
    __syncthreads();
    XcdBarrier bar; bar.wave = F.wave; bar.bar = (unsigned*)(F.ctl + CW_BAR); bar.x = 0; bar.st = nullptr;
    if (!MK_SPLIT) bar = xcd_barrier_post((unsigned*)(F.ctl + CW_BAR), F.MISC + 8, F.wave);
    const int lo = args.ph_lo, hi = args.ph_hi;
#define IN(k) (lo <= (k) && (k) < hi)
#define SEAM(k) do { if (IN(k) && IN((k) + 1)) xcd_barrier(bar); } while (0)

    if (IN(PH_P0)) { p0_prologue(F); }
    SEAM(PH_P0);
    if (IN(PH_GKV)) {
        pg8::Gemm g{(const bf16*)(ws + WS_MEMN), (const bf16*)(ws + WS_WXKV), MROWS, 1024, D}; pg8::StaticOrder S; S.init(MROWS, 1024, F.G, (int)blockIdx.x);
        pg8::EpiRowScale<0> E{(bf16*)(ws + WS_KV), 1024, nullptr, nullptr};
        pg8::gemm_phase<pg8::EpiRowScale<0>, pg8::StaticOrder, true, true>(F.lds + RING_OFF, g, S, E, F.wave);
    }
    layer_phases<0>(F, bar, lo, hi);
    layer_phases<1>(F, bar, lo, hi);
    if (IN(PH_FN)) { fn_finalnorm(F, (const float*)(ws + WS_SSQ)); }
#undef IN
#undef SEAM
}

extern "C" void kernel_launch(void* const* d_in, const int* in_sizes, int n_in, void* d_out, int out_size, void* d_ws, size_t ws_size, hipStream_t stream) {
    static int grid = 0;
    if (grid == 0) {
        if (n_in != 17 || in_sizes[0] != M * D || out_size != M * D || ws_size < WS_END) { fprintf(stderr, "kernel_launch: unexpected shapes (n_in %d, in0 %d, out %d, ws %zu); nothing launched\n", n_in, n_in > 0 ? in_sizes[0] : -1, out_size, ws_size); grid = -1; return; }
        int dev = 0, cus = 0, per_cu = 0;
        if (hipGetDevice(&dev) != hipSuccess || hipDeviceGetAttribute(&cus, hipDeviceAttributeMultiprocessorCount, dev) != hipSuccess) { grid = -1; return; }
        if (hipFuncSetAttribute((const void*)mk_fwd, hipFuncAttributeMaxDynamicSharedMemorySize, LDS_BYTES) != hipSuccess) { grid = -1; return; }
        if (hipOccupancyMaxActiveBlocksPerMultiprocessor(&per_cu, (const void*)mk_fwd, NWAVES * 64, LDS_BYTES) != hipSuccess || per_cu < 1) { fprintf(stderr, "kernel_launch: occupancy query says %d\n", per_cu); }
        (void)hipGetLastError();
        grid = cus;
    }
    if (grid < 0) return;
    if (hipMemsetAsync((char*)d_ws + WS_CTL, 0, CTL_ZERO_BYTES, stream) != hipSuccess) return;
    Args a{};
    for (int i = 0; i < 17; ++i) a.in[i] = (const float*)d_in[i];
    a.out = (float*)d_out; a.ws = (unsigned char*)d_ws;
#if MK_SPLIT
    for (int p = 0; p < NPHASE; ++p) { a.ph_lo = p; a.ph_hi = p + 1; hipLaunchKernelGGL(mk_fwd, dim3(grid), dim3(NWAVES * 64), LDS_BYTES, stream, a); }
#else
    a.ph_lo = 0; a.ph_hi = NPHASE; hipLaunchKernelGGL(mk_fwd, dim3(grid), dim3(NWAVES * 64), LDS_BYTES, stream, a);
#endif
}
```

```cpp
#include <hip/hip_runtime.h>
#include <cstdio>
#include <cstdint>
namespace pg8 {
#define PG8_LAS __attribute__((address_space(3)))
typedef unsigned short bf16_t;
typedef short bf16x8 __attribute__((ext_vector_type(8)));
typedef float f32x4 __attribute__((ext_vector_type(4)));
typedef unsigned u32x4 __attribute__((ext_vector_type(4)));
constexpr int BM = 256, BK = 64, HALF = 128, HTB = HALF * BK * 2  , STAGE_BYTES = 8 * HTB, NXCD = 8, WGM = 8;

__host__ __device__ __forceinline__ int lds_byte(int r, int c) { return r * 128 + ((((c >> 3) ^ ((r >> 1) & 7))) << 4) + (c & 7) * 2; }
__host__ __device__ __forceinline__ void stage_rc(int b, int& R, int& C) { R = b >> 7; C = ((((b & 127) >> 4) ^ ((R >> 1) & 7))) * 8; }
__host__ __device__ __forceinline__ int perm32(int rho) { const int n = rho >> 4, i = rho & 15; return 8 * (i >> 2) + 4 * n + (i & 3); }

struct Unit { int pm, pn; };
struct Gemm { const bf16_t* A; const bf16_t* Bt; int M, N, K; const float* hr = nullptr; };

struct StaticOrder {
    int nM, nN, nwg, G, c;
    __host__ __device__ void init(int M, int N, int G_, int c_) { nM = M / BM; nN = N / BM; nwg = nM * nN; G = G_; c = c_; }
    __host__ __device__ bool next(int i, Unit& u) const {
        const long L = (long)i * G + c; if (L >= nwg) return false;
        int wgid = (int)L; { const int q = nwg / NXCD, r = nwg % NXCD, xcd = wgid % NXCD, off = wgid / NXCD; wgid = (xcd < r ? xcd * (q + 1) : r * (q + 1) + (xcd - r) * q) + off; }
        const int nig = WGM * nN, gid = wgid / nig, fm = gid * WGM, gsz = (nM - fm) < WGM ? (nM - fm) : WGM;
        u.pm = fm + ((wgid % nig) % gsz); u.pn = (wgid % nig) / gsz; return true;
    }
    __device__ __forceinline__ void a_ready(const Unit&) const {}
    __device__ __forceinline__ void done(const Unit&) const {}
};

struct PanelOrder {
    int pm, nN;
    __device__ __forceinline__ bool next(int i, Unit& u) const { if (i >= nN) return false; u.pm = pm; u.pn = i; return true; }
    __device__ __forceinline__ void a_ready(const Unit&) const {}
    __device__ __forceinline__ void done(const Unit&) const {}
};

__device__ __forceinline__ unsigned cvt_pk_bf16(float lo, float hi) { unsigned r; asm volatile("v_cvt_pk_bf16_f32 %0, %1, %2" : "=v"(r) : "v"(lo), "v"(hi)); return r; }
typedef float f32x2 __attribute__((ext_vector_type(2)));
constexpr float RMS_EPS = 1e-6f;
__device__ __forceinline__ float row_rs(const float* ssq, int row) {
    const f32x4* p = (const f32x4*)(ssq + (size_t)row * 16);
    const f32x4 a = p[0], b = p[1], c = p[2], d = p[3];
    const float s = (((a[0] + a[1]) + (a[2] + a[3])) + ((b[0] + b[1]) + (b[2] + b[3]))) + (((c[0] + c[1]) + (c[2] + c[3])) + ((d[0] + d[1]) + (d[2] + d[3])));
    return __builtin_amdgcn_rsqf(s * (1.0f / 1024.0f) + RMS_EPS);
}
template <int ACT, bool NT = false> struct EpiRowScale {
    static constexpr bool PERM = true, AFTER_DRAIN = false; static constexpr int MIN_VMEM = 16;
    bf16_t* O; int ldc; const float* ssq; float* kmp;
    __device__ __forceinline__ void operator()(const f32x4 (&acc)[2][2][4][2], const Unit& u, int wr, int wc, int fr, int fq) const {
        const int row0 = u.pm * BM + wr * 64 + fr, col0 = u.pn * BM + wc * 64 + 8 * fq;
        float rs[2][4];
        if (ssq) {
            f32x4 q4[2][4];
#pragma unroll
            for (int ai = 0; ai < 2; ++ai)
#pragma unroll
                for (int m = 0; m < 4; ++m) q4[ai][m] = *(const f32x4*)(ssq + (size_t)(row0 + ai * HALF + m * 16) * 16 + 4 * fq);
#pragma unroll
            for (int ai = 0; ai < 2; ++ai)
#pragma unroll
                for (int m = 0; m < 4; ++m) { float s = (q4[ai][m][0] + q4[ai][m][1]) + (q4[ai][m][2] + q4[ai][m][3]); s += __shfl_xor(s, 16); s += __shfl_xor(s, 32);
                    rs[ai][m] = __builtin_amdgcn_rsqf(s * (1.0f / 1024.0f) + RMS_EPS); }
        } else {
#pragma unroll
            for (int ai = 0; ai < 2; ++ai)
#pragma unroll
                for (int m = 0; m < 4; ++m) rs[ai][m] = 1.0f;
        }
        if (ACT == 0 && kmp != nullptr && u.pn == 9) {
#pragma unroll
            for (int bj = 0; bj < 2; ++bj)
#pragma unroll
                for (int n = 0; n < 2; ++n) {
                    f32x4 cs = {0.f, 0.f, 0.f, 0.f};
#pragma unroll
                    for (int ai = 0; ai < 2; ++ai)
#pragma unroll
                        for (int m = 0; m < 4; ++m) { float rk = rs[ai][m]; asm volatile("" : "+v"(rk)); cs += acc[ai][bj][m][n] * rk; }
#pragma unroll
                    for (int e = 0; e < 4; ++e) { float v = cs[e]; v += __shfl_xor(v, 1); v += __shfl_xor(v, 2); v += __shfl_xor(v, 4); v += __shfl_xor(v, 8); cs[e] = v; }
                    if (fr == 0) *(f32x4*)(kmp + ((size_t)u.pm * 2 + wr) * 256 + wc * 64 + bj * 32 + 8 * fq + 4 * n) = cs;
                }
        }
        const int odd = fr & 1;
        bf16_t* pbase = O + (size_t)(row0 - odd) * ldc + col0 + odd * 32;
#pragma unroll
        for (int ai = 0; ai < 2; ++ai)
#pragma unroll
            for (int m = 0; m < 4; ++m) {
                u32x4 w[2];
#pragma unroll
                for (int bj = 0; bj < 2; ++bj) {
                    f32x4 v0 = acc[ai][bj][m][0] * rs[ai][m], v1 = acc[ai][bj][m][1] * rs[ai][m];
                    if (ACT == 1) {
#pragma unroll
                        for (int e = 0; e < 4; ++e) { const float a = __builtin_fmaxf(v0[e], 0.f), b = __builtin_fmaxf(v1[e], 0.f); v0[e] = a * a; v1[e] = b * b; }
                    }
                    w[bj].x = cvt_pk_bf16(v0[0], v0[1]); w[bj].y = cvt_pk_bf16(v0[2], v0[3]); w[bj].z = cvt_pk_bf16(v1[0], v1[1]); w[bj].w = cvt_pk_bf16(v1[2], v1[3]);
                }
                const u32x4 snd = odd ? w[0] : w[1]; u32x4 rcv;
#pragma unroll
                for (int e = 0; e < 4; ++e) rcv[e] = (unsigned)__builtin_amdgcn_update_dpp(0, (int)snd[e], 0xB1, 0xF, 0xF, true);
                bf16_t* p = pbase + (size_t)(ai * HALF + m * 16) * ldc;
                if (NT) { __builtin_nontemporal_store(odd ? rcv : w[0], (u32x4*)p); __builtin_nontemporal_store(odd ? w[1] : rcv, (u32x4*)(p + ldc)); }
                else { *(u32x4*)p = odd ? rcv : w[0]; *(u32x4*)(p + ldc) = odd ? w[1] : rcv; }
            }
    }
};
template <bool DEEP> struct EpiResid {
    static constexpr bool PERM = true, AFTER_DRAIN = false; static constexpr int MIN_VMEM = 16;
    bf16_t* xb; float* ssq;
    __device__ __forceinline__ void operator()(const f32x4 (&acc)[2][2][4][2], const Unit& u, int wr, int wc, int fr, int fq) const {
        const int row0 = u.pm * BM + wr * 64 + fr, col0 = u.pn * BM + wc * 64 + 8 * fq, slot = u.pn * 4 + wc;
        char* const xbase = (char*)xb; char* const sbase = (char*)ssq;
        const int odd = fr & 1;
        const unsigned xoff0 = ((unsigned)(row0 - odd) * 1024u + (unsigned)(col0 + odd * 32)) * 2u, soff0 = ((unsigned)row0 * 16u + (unsigned)slot) * 4u;
#define ERL(dst, am_) do { _Pragma("unroll") for (int mm = 0; mm < 2; ++mm) _Pragma("unroll") for (int rr = 0; rr < 2; ++rr) \
            dst[mm][rr] = *(const u32x4*)(xbase + (xoff0 + (unsigned)((((am_) >> 1) * HALF + (((am_) & 1) * 2 + mm) * 16 + rr) * 2048))); } while (0)
#define EDPP(x) ((unsigned)__builtin_amdgcn_update_dpp(0, (int)(x), 0xB1, 0xF, 0xF, true))
        u32x4 xin[2][2], xnx[2][2];
        ERL(xin, 0);
#pragma unroll
        for (int am = 0; am < 4; ++am) {
            const int ai = am >> 1;
            if (DEEP) { if (am < 3) ERL(xnx, am + 1); }
#pragma unroll
            for (int mm = 0; mm < 2; ++mm) {
                const int m = (am & 1) * 2 + mm;
                const u32x4 la = xin[mm][0], lb = xin[mm][1];
                const u32x4 snd = odd ? la : lb; u32x4 rcv;
#pragma unroll
                for (int e = 0; e < 4; ++e) rcv[e] = EDPP(snd[e]);
                const u32x4 b0 = odd ? rcv : la, b1 = odd ? lb : rcv;
                u32x4 w[2]; float ss = 0.f;
#pragma unroll
                for (int bj = 0; bj < 2; ++bj) {
                    const u32x4 b = bj ? b1 : b0;
                    const f32x4 a0 = acc[ai][bj][m][0], a1 = acc[ai][bj][m][1];
                    w[bj].x = cvt_pk_bf16(a0[0] + __builtin_bit_cast(float, b.x << 16), a0[1] + __builtin_bit_cast(float, b.x & 0xffff0000u));
                    w[bj].y = cvt_pk_bf16(a0[2] + __builtin_bit_cast(float, b.y << 16), a0[3] + __builtin_bit_cast(float, b.y & 0xffff0000u));
                    w[bj].z = cvt_pk_bf16(a1[0] + __builtin_bit_cast(float, b.z << 16), a1[1] + __builtin_bit_cast(float, b.z & 0xffff0000u));
                    w[bj].w = cvt_pk_bf16(a1[2] + __builtin_bit_cast(float, b.w << 16), a1[3] + __builtin_bit_cast(float, b.w & 0xffff0000u));
#pragma unroll
                    for (int e = 0; e < 4; ++e) { const float lo = __builtin_bit_cast(float, w[bj][e] << 16), hi = __builtin_bit_cast(float, w[bj][e] & 0xffff0000u); ss += lo * lo + hi * hi; }
                }
                const u32x4 snd2 = odd ? w[0] : w[1]; u32x4 rcv2;
#pragma unroll
                for (int e = 0; e < 4; ++e) rcv2[e] = EDPP(snd2[e]);
                char* p = xbase + (xoff0 + (unsigned)((ai * HALF + m * 16) * 2048));
                if (DEEP) { __builtin_nontemporal_store(odd ? rcv2 : w[0], (u32x4*)p); __builtin_nontemporal_store(odd ? w[1] : rcv2, (u32x4*)(p + 2048)); }
                else { *(u32x4*)p = odd ? rcv2 : w[0]; *(u32x4*)(p + 2048) = odd ? w[1] : rcv2; }
                ss += __shfl_xor(ss, 16); ss += __shfl_xor(ss, 32);
                if (fq == 0) *(float*)(sbase + (soff0 + (unsigned)((ai * HALF + m * 16) * 64))) = ss;
            }
            asm volatile("" ::: "memory");
            if (DEEP) {
#pragma unroll
                for (int mm = 0; mm < 2; ++mm)
#pragma unroll
                    for (int rr = 0; rr < 2; ++rr) xin[mm][rr] = xnx[mm][rr];
            } else { if (am < 3) ERL(xin, am + 1); }
        }
#undef EDPP
#undef ERL
    }
};

__device__ __forceinline__ int pg8_lane_id() { int l; asm volatile("v_mbcnt_lo_u32_b32 %0, -1, 0\n\tv_mbcnt_hi_u32_b32 %0, -1, %0" : "=v"(l)); return l; }
template <class Epi, class Sched, bool ALIGN_EPI = false, bool SP2 = false, bool HORNER = false>
__device__ __forceinline__ void gemm_phase(PG8_LAS unsigned char* lds, const Gemm g, const Sched& S, const Epi& E, const int wave_) {
    const int wid = wave_, lane = pg8_lane_id(), tid = wid * 64 + lane, wr = wid >> 2, wc = wid & 3, fr = lane & 15, fq = lane >> 4;
    const int K = g.K, nt = K / BK;
    unsigned voffA, voffB;
    { int R, C; stage_rc(tid * 16, R, C); const int Rb = 64 * (R >> 5) + perm32(R & 31);
      voffA = (unsigned)(R * K + C) * 2u; voffB = (unsigned)(Rb * K + C) * 2u; }
    const size_t pstepA = (size_t)64 * K * 2, pstepB = (size_t)128 * K * 2, hstepB = (size_t)32 * K * 2;
    const size_t kstep = (size_t)(BK * 2);
    const size_t hstep = (size_t)HALF * K * 2;
    const size_t tstep = 2 * hstep;
    const unsigned ldsw = (unsigned)wid * 1024u;
    const int aoff0 = lds_byte(wr * 64 + fr, fq * 8), boff0 = lds_byte(wc * 32 + fr, fq * 8);
#define PG8_SA(b, h) (((b) * 2 + (h)) * HTB)
#define PG8_SB(b, h) ((4 + (b) * 2 + (h)) * HTB)
#define PG8_STAGE4(bufoff, gbase, voff, pst) do { _Pragma("unroll") for (int _i = 0; _i < 2; ++_i) \
        __builtin_amdgcn_global_load_lds((const unsigned*)((const char*)(gbase) + _i * (pst) + (voff)), (PG8_LAS unsigned*)(lds + (bufoff) + ldsw + _i * 8192), 16, 0, 0); } while (0)
#define PG8_LDA(dst, b, h) do { int a1_ = aoff0 ^ 64; asm volatile("" : "+v"(a1_)); _Pragma("unroll") for (int m = 0; m < 4; ++m) _Pragma("unroll") for (int k = 0; k < 2; ++k) dst[m][k] = *(const PG8_LAS bf16x8*)(lds + PG8_SA(b, h) + (k == 0 ? aoff0 : a1_) + m * 2048); } while (0)
#define PG8_LDB(dst, b, h) do { int b1_ = boff0 ^ 64; asm volatile("" : "+v"(b1_)); _Pragma("unroll") for (int n = 0; n < 2; ++n) _Pragma("unroll") for (int k = 0; k < 2; ++k) dst[n][k] = *(const PG8_LAS bf16x8*)(lds + PG8_SB(b, h) + (k == 0 ? boff0 : b1_) + n * 2048); } while (0)
#define PG8_MMA(ai, bj, At, Bt) do { __builtin_amdgcn_s_setprio(1); _Pragma("unroll") for (int m = 0; m < 4; ++m) _Pragma("unroll") for (int n = 0; n < 2; ++n) _Pragma("unroll") for (int k = 0; k < 2; ++k) \
        acc[ai][bj][m][n] = __builtin_amdgcn_mfma_f32_16x16x32_bf16(Bt[n][k], At[m][k], acc[ai][bj][m][n], 0, 0, 0); __builtin_amdgcn_s_setprio(0); } while (0)
#define PG8_WAIT_V(n) asm volatile("s_waitcnt vmcnt(" #n ")" ::: "memory")
#define PG8_WAIT_L(n) asm volatile("s_waitcnt lgkmcnt(" #n ")" ::: "memory")
#define PG8_BAR __builtin_amdgcn_s_barrier()
#define PG8_SCHED __builtin_amdgcn_sched_barrier(0)
    Unit cur, nxt; int ui = 0;
    if (!S.next(0, cur)) return;
#define PG8_HSCALE(buf, k) do { const int l_ = pg8_lane_id(); PG8_LAS const float* hp_ = (PG8_LAS const float*)(lds + STAGE_BYTES) + (buf) * 1024 + ((wid >> 2) * 64 + (l_ & 15)) * 4 + (k); \
        _Pragma("unroll") for (int a_ = 0; a_ < 2; ++a_) _Pragma("unroll") for (int m_ = 0; m_ < 4; m_ += 2) { \
            float f0_ = hp_[(128 * a_ + 16 * m_) * 4], f1_ = hp_[(128 * a_ + 16 * m_ + 16) * 4]; asm volatile("s_waitcnt lgkmcnt(0)" : "+v"(f0_), "+v"(f1_)); \
            _Pragma("unroll") for (int b_ = 0; b_ < 2; ++b_) _Pragma("unroll") for (int n_ = 0; n_ < 2; ++n_) { acc[a_][b_][m_][n_] *= f0_; acc[a_][b_][m_ + 1][n_] *= f1_; } \
            __builtin_amdgcn_sched_barrier(0); } } while (0)
#define PG8_HFETCH(dst, pm_) do { const int t_ = wid * 64 + pg8_lane_id(); if (t_ < 256) dst = *(const f32x4*)(g.hr + ((size_t)(pm_) * BM + t_) * 4); } while (0)
#define PG8_HPARK(src, buf) do { const int t_ = wid * 64 + pg8_lane_id(); if (t_ < 256) *(PG8_LAS f32x4*)((PG8_LAS float*)(lds + STAGE_BYTES) + (buf) * 1024 + t_ * 4) = src; } while (0)
    if constexpr (HORNER) { f32x4 h0 = {1.f, 1.f, 1.f, 1.f}; PG8_HFETCH(h0, cur.pm); PG8_HPARK(h0, 0); }
    f32x4 acc[2][2][4][2];
#pragma unroll
    for (int a = 0; a < 2; ++a)
#pragma unroll
        for (int b = 0; b < 2; ++b)
#pragma unroll
            for (int m = 0; m < 4; ++m)
#pragma unroll
                for (int n = 0; n < 2; ++n) acc[a][b][m][n] = (f32x4){0.f, 0.f, 0.f, 0.f};
    bf16x8 At[4][2], B0[2][2], B1[2][2];
    const char* cA = (const char*)g.A + (size_t)cur.pm * tstep; const char* cB = (const char*)g.Bt + (size_t)cur.pn * tstep;
    S.a_ready(cur);
    if constexpr (SP2) {
        PG8_STAGE4(PG8_SB(0, 0), cB, voffB, pstepB); PG8_STAGE4(PG8_SB(0, 1), cB + hstepB, voffB, pstepB); PG8_STAGE4(PG8_SA(0, 0), cA, voffA, pstepA); PG8_STAGE4(PG8_SA(0, 1), cA + hstep, voffA, pstepA);
        if (wr == 1) PG8_BAR;
        PG8_WAIT_V(2); PG8_BAR;
        PG8_STAGE4(PG8_SB(1, 0), cB + kstep, voffB, pstepB); PG8_STAGE4(PG8_SA(1, 0), cA + kstep, voffA, pstepA); PG8_STAGE4(PG8_SB(1, 1), cB + hstepB + kstep, voffB, pstepB);
        PG8_WAIT_V(6); PG8_BAR;
    } else {
        PG8_STAGE4(PG8_SB(0, 0), cB, voffB, pstepB); PG8_STAGE4(PG8_SA(0, 0), cA, voffA, pstepA); PG8_STAGE4(PG8_SB(0, 1), cB + hstepB, voffB, pstepB); PG8_STAGE4(PG8_SA(0, 1), cA + hstep, voffA, pstepA);
        if (wr == 1) PG8_BAR;
        PG8_WAIT_V(4); PG8_BAR;
        PG8_STAGE4(PG8_SB(1, 0), cB + kstep, voffB, pstepB); PG8_STAGE4(PG8_SA(1, 0), cA + kstep, voffA, pstepA); PG8_STAGE4(PG8_SB(1, 1), cB + hstepB + kstep, voffB, pstepB);
        PG8_WAIT_V(6); PG8_BAR;
    }
    for (;;) {
        const bool has_next = S.next(ui + 1, nxt);
        const char* nA = has_next ? (const char*)g.A + (size_t)nxt.pm * tstep : cA; const char* nB = has_next ? (const char*)g.Bt + (size_t)nxt.pn * tstep : cB;
        for (int tb = 0; tb < nt; tb += (HORNER ? 4 : nt)) {
        const int te = HORNER ? tb + 4 : nt;
        for (int t = tb; t < te; t += 2) {
            const bool last = (t == nt - 2);
            const char* a1 = cA + (size_t)(t + 1) * kstep;
            const char* a2 = last ? nA : cA + (size_t)(t + 2) * kstep; const char* b2 = last ? nB : cB + (size_t)(t + 2) * kstep;
            const char* a3 = a2 + kstep; const char* b3 = b2 + kstep;
            if (last && has_next) S.a_ready(nxt);
            if constexpr (SP2) {
            PG8_LDB(B0, 0, 0); PG8_LDB(B1, 0, 1); PG8_SCHED; PG8_LDA(At, 0, 0); PG8_STAGE4(PG8_SA(1, 1), a1 + hstep, voffA, pstepA);
            PG8_WAIT_V(8); PG8_WAIT_L(0); PG8_BAR; PG8_MMA(0, 0, At, B0); PG8_MMA(0, 1, At, B1); PG8_BAR; PG8_SCHED;
            PG8_LDA(At, 0, 1); PG8_STAGE4(PG8_SB(0, 0), b2, voffB, pstepB); PG8_STAGE4(PG8_SB(0, 1), b2 + hstepB, voffB, pstepB); PG8_STAGE4(PG8_SA(0, 0), a2, voffA, pstepA);
            PG8_WAIT_V(8); PG8_WAIT_L(0); PG8_BAR; PG8_MMA(1, 0, At, B0); PG8_MMA(1, 1, At, B1); PG8_BAR; PG8_SCHED;
            PG8_LDB(B0, 1, 0); PG8_LDB(B1, 1, 1); PG8_SCHED; PG8_LDA(At, 1, 0); PG8_STAGE4(PG8_SA(0, 1), a2 + hstep, voffA, pstepA);
            PG8_WAIT_V(8); PG8_WAIT_L(0); PG8_BAR; PG8_MMA(0, 0, At, B0); PG8_MMA(0, 1, At, B1); PG8_BAR; PG8_SCHED;
            PG8_LDA(At, 1, 1); PG8_STAGE4(PG8_SB(1, 0), b3, voffB, pstepB); PG8_STAGE4(PG8_SB(1, 1), b3 + hstepB, voffB, pstepB); PG8_STAGE4(PG8_SA(1, 0), a3, voffA, pstepA);
            PG8_WAIT_V(8); PG8_WAIT_L(0); PG8_BAR; PG8_MMA(1, 0, At, B0); PG8_MMA(1, 1, At, B1); PG8_BAR; PG8_SCHED;
            } else {
            PG8_LDB(B0, 0, 0); PG8_SCHED; PG8_LDA(At, 0, 0); PG8_STAGE4(PG8_SA(1, 1), a1 + hstep, voffA, pstepA);
            PG8_WAIT_L(8); PG8_BAR; PG8_WAIT_L(0); PG8_MMA(0, 0, At, B0); PG8_BAR; PG8_SCHED;
            PG8_LDB(B1, 0, 1); PG8_STAGE4(PG8_SB(0, 0), b2, voffB, pstepB);
            PG8_BAR; PG8_WAIT_L(0); PG8_MMA(0, 1, At, B1); PG8_BAR;
            PG8_LDA(At, 0, 1); PG8_STAGE4(PG8_SA(0, 0), a2, voffA, pstepA);
            PG8_BAR; PG8_WAIT_L(0); PG8_MMA(1, 0, At, B0); PG8_BAR; PG8_SCHED;
            PG8_STAGE4(PG8_SB(0, 1), b2 + hstepB, voffB, pstepB);
            PG8_WAIT_V(6); PG8_BAR; PG8_MMA(1, 1, At, B1); PG8_BAR;
            PG8_LDB(B0, 1, 0); PG8_SCHED; PG8_LDA(At, 1, 0); PG8_STAGE4(PG8_SA(0, 1), a2 + hstep, voffA, pstepA);
            PG8_WAIT_L(8); PG8_BAR; PG8_WAIT_L(0); PG8_MMA(0, 0, At, B0); PG8_BAR; PG8_SCHED;
            PG8_LDB(B1, 1, 1); PG8_STAGE4(PG8_SB(1, 0), b3, voffB, pstepB);
            PG8_BAR; PG8_WAIT_L(0); PG8_MMA(0, 1, At, B1); PG8_BAR;
            PG8_LDA(At, 1, 1); PG8_STAGE4(PG8_SA(1, 0), a3, voffA, pstepA);
            PG8_BAR; PG8_WAIT_L(0); PG8_MMA(1, 0, At, B0); PG8_BAR; PG8_SCHED;
            PG8_STAGE4(PG8_SB(1, 1), b3 + hstepB, voffB, pstepB);
            PG8_WAIT_V(6); PG8_BAR; PG8_MMA(1, 1, At, B1); PG8_BAR;
            }
        }
        if constexpr (HORNER) PG8_HSCALE(ui & 1, tb >> 2);
        }
        if constexpr (HORNER) {
            f32x4 hn = {1.f, 1.f, 1.f, 1.f};
            if (has_next) { PG8_HFETCH(hn, nxt.pm); PG8_HPARK(hn, (ui + 1) & 1); }
        }
        if constexpr (ALIGN_EPI) { if (wr == 0) PG8_BAR; }
        if constexpr (!Epi::AFTER_DRAIN) { E(acc, cur, wr, wc, fr, fq); S.done(cur); }
        if (!has_next) break;
#pragma unroll
        for (int a = 0; a < 2; ++a)
#pragma unroll
            for (int b = 0; b < 2; ++b)
#pragma unroll
                for (int m = 0; m < 4; ++m)
#pragma unroll
                    for (int n = 0; n < 2; ++n) acc[a][b][m][n] = (f32x4){0.f, 0.f, 0.f, 0.f};
        cur = nxt; cA = nA; cB = nB; ++ui;
        if constexpr (ALIGN_EPI) { if (wr == 1) PG8_BAR; }
    }
    PG8_WAIT_V(0);
    if constexpr (!ALIGN_EPI) { if (wr == 0) PG8_BAR; }
    PG8_BAR;
    if constexpr (Epi::AFTER_DRAIN) { E.fused(acc, cur, wr, wc, fr, fq, lds, wid, lane); S.done(cur); }
#undef PG8_SA
#undef PG8_SB
#undef PG8_STAGE4
#undef PG8_LDA
#undef PG8_LDB
#undef PG8_MMA
#undef PG8_WAIT_V
#undef PG8_WAIT_L
#undef PG8_BAR
#undef PG8_SCHED
}
}
#define GAS __attribute__((address_space(1)))
#define LAS __attribute__((address_space(3)))
typedef unsigned short bf16;
typedef unsigned v4u __attribute__((ext_vector_type(4)));
typedef float f32x4 __attribute__((ext_vector_type(4)));
typedef short bf16x8 __attribute__((ext_vector_type(8)));
typedef GAS unsigned gu32;
typedef GAS unsigned long long gu64;
#define RLX_AGENT __ATOMIC_RELAXED, __HIP_MEMORY_SCOPE_AGENT
#define LDS_WAIT() asm volatile("s_waitcnt lgkmcnt(0)" ::: "memory")
#define VM_WAIT() asm volatile("s_waitcnt vmcnt(0)" ::: "memory")
__device__ __forceinline__ unsigned long long rt() { return __builtin_amdgcn_s_memrealtime(); }
__device__ __forceinline__ unsigned f2bf(float f) { unsigned u = __builtin_bit_cast(unsigned, f); return (u + 0x7fffu + ((u >> 16) & 1u)) >> 16; }
__device__ __forceinline__ unsigned pk2(float lo, float hi) { return f2bf(lo) | (f2bf(hi) << 16); }
__device__ __forceinline__ int lane_id() { int l; asm volatile("v_mbcnt_lo_u32_b32 %0, -1, 0\n\tv_mbcnt_hi_u32_b32 %0, -1, %0" : "=v"(l)); return l; }
#define XB_TMO      128
#define XB_XCNT(j)  (256  + 64 * (j))
#define XB_XSUB(j)  (1280 + 64 * (j))
#define XB_XGEN(j)  (2304 + 64 * (j))
#define XB_TOP      3328
#define XB_TOPGEN   3392
#define XCD_BAR_WORDS 3456
#define XB_SPIN_CAP (1u << 18)

__device__ __forceinline__ unsigned xb_ld(unsigned* p)              { return __hip_atomic_load(p, __ATOMIC_RELAXED, __HIP_MEMORY_SCOPE_AGENT); }
__device__ __forceinline__ unsigned xb_add(unsigned* p, unsigned v) { return __hip_atomic_fetch_add(p, v, __ATOMIC_RELAXED, __HIP_MEMORY_SCOPE_AGENT); }
__device__ __forceinline__ unsigned xb_xcc_id() { return (unsigned)__builtin_amdgcn_s_getreg((3 << 11) | 20) & 0xFu; }
#define XB_SPIN(cond, bar) do { unsigned _sp = 0; while (cond) { __builtin_amdgcn_s_sleep(1); \
    if ((++_sp & 255u) == 0u) { if (xb_ld(&(bar)[XB_TMO])) break; if (_sp > XB_SPIN_CAP) { atomicAdd(&(bar)[XB_TMO], 1u); break; } } } } while (0)

struct XcdBarrier {
    int wave;
    unsigned* bar; unsigned x;
    volatile LAS unsigned* st;
};

__device__ __forceinline__ XcdBarrier xcd_barrier_post(unsigned* bar, volatile LAS unsigned* st, int wave) {
    XcdBarrier b; b.wave = wave; b.bar = bar; b.x = xb_xcc_id(); b.st = st;
    if (wave == 0 && lane_id() == 0) (void)xb_add(&bar[XB_XCNT(b.x)], 1u);
    return b;
}
__device__ __forceinline__ void xcd_barrier_complete(unsigned* bar, unsigned x, unsigned& nloc, unsigned& nx) {
    const unsigned G = gridDim.x * gridDim.y * gridDim.z;
    unsigned sum, cnt, mine, sp = 0u;
    for (;;) {
        sum = 0u; cnt = 0u; mine = 0u;
#pragma unroll
        for (unsigned j = 0; j < 16; ++j) { const unsigned c = xb_ld(&bar[XB_XCNT(j)]); sum += c; cnt += (c > 0u) ? 1u : 0u; mine = (j == x) ? c : mine; }
        if (sum == G) break;
        __builtin_amdgcn_s_sleep(1);
        if ((++sp & 255u) == 0u) { if (xb_ld(&bar[XB_TMO])) break; if (sp > XB_SPIN_CAP) { atomicAdd(&bar[XB_TMO], 1u); break; } }
    }
    nloc = mine > 0u ? mine : 1u; nx = cnt > 0u ? cnt : 1u;
}

__device__ __forceinline__ void xcd_barrier(const XcdBarrier& b) {
    asm volatile("s_waitcnt vmcnt(0)" ::: "memory");
    __syncthreads();
    if (b.wave == 0 && lane_id() == 0) {
        unsigned* bar = b.bar;
        __builtin_amdgcn_s_waitcnt(0);
        unsigned nloc = b.st[0], nx = b.st[1];
        if (nloc == 0u) { xcd_barrier_complete(bar, b.x, nloc, nx); b.st[0] = nloc; b.st[1] = nx; }
        const unsigned old = xb_add(&bar[XB_XSUB(b.x)], 1u);
        const unsigned gen = old / nloc;
        if (old + 1u == (gen + 1u) * nloc) {
            __builtin_amdgcn_fence(__ATOMIC_RELEASE, "agent");
            asm volatile("s_waitcnt vmcnt(0)" ::: "memory");
            const unsigned og = xb_add(&bar[XB_TOP], 1u);
            const unsigned tg = og / nx;
            if (og + 1u == (tg + 1u) * nx) xb_add(&bar[XB_TOPGEN], 1u);
            else XB_SPIN(xb_ld(&bar[XB_TOPGEN]) == tg, bar);
            __builtin_amdgcn_fence(__ATOMIC_ACQUIRE, "agent");
            xb_add(&bar[XB_XGEN(b.x)], 1u);
            asm volatile("s_waitcnt vmcnt(0)" ::: "memory");
        } else {
            XB_SPIN(xb_ld(&bar[XB_XGEN(b.x)]) == gen, bar);
            __builtin_amdgcn_fence(__ATOMIC_ACQUIRE, "agent");
            asm volatile("s_waitcnt vmcnt(0)" ::: "memory");
        }
    }
    __syncthreads();
}
constexpr int NWAVES = 8;
constexpr int BATCH = 32, SEQ = 2048, D = 1024, M = BATCH * SEQ, INW = 2816, FF = 4096, MEMLEN = 256, MROWS = BATCH * MEMLEN, XW = 256, DEPTH = 2;
constexpr float NORM_EPS = 1e-6f;
constexpr float LOG2E = 1.4426950408889634f;
constexpr float C2 = 0.125f * LOG2E;
constexpr int COL_AQ = 0, COL_AK = 256, COL_AV = 512, COL_BQ = 768, COL_BK = 1024, COL_BV = 1280, COL_CQ = 1536, COL_CK = 1792, COL_CV = 1920, COL_DQ = 2048, COL_DK = 2304, COL_DV = 2560;
constexpr int BT_STRIDE = 2112;

constexpr size_t MiB = 1u << 20;
constexpr size_t WS_CTL = 0, CTL_ZERO_BYTES = 32768;
constexpr size_t WS_BT = 1 * MiB;
constexpr size_t WS_KMEAN = 1 * MiB + 512 * 1024;
constexpr size_t WS_W = 2 * MiB, W_LAYER = 26 * MiB;
constexpr size_t WO_IN = 0, WO_OUT = WO_IN + (size_t)INW * D * 2, WO_XQ = WO_OUT + (size_t)D * D * 2, WO_XO = WO_XQ + (size_t)XW * D * 2, WO_UP = WO_XO + (size_t)D * XW * 2, WO_DOWN = WO_UP + (size_t)FF * D * 2;
static_assert(WO_DOWN + (size_t)D * FF * 2 <= W_LAYER, "weights per layer");
constexpr size_t WS_WXKV = WS_W + 2 * W_LAYER;
constexpr size_t WS_SSQ = 56 * MiB;
constexpr size_t WS_MEMN = 68 * MiB;
constexpr size_t WS_KV = 84 * MiB;
constexpr size_t WS_Q2 = 100 * MiB;
constexpr size_t WS_LSE = 132 * MiB;
constexpr size_t WS_XB = 136 * MiB;
constexpr size_t WS_PROJ = 264 * MiB;
constexpr size_t WS_Y = 616 * MiB;
constexpr size_t WS_YA1 = 744 * MiB, WS_YA2 = 776 * MiB;
constexpr size_t WS_H = 264 * MiB;
constexpr size_t WS_O2 = 808 * MiB;
constexpr size_t WS_SSQY = 840 * MiB;
constexpr size_t WS_RAT = 844 * MiB;
constexpr size_t WS_END = 848 * MiB;
static_assert(WS_PROJ + (size_t)M * INW * 2 <= WS_Y && WS_H + (size_t)M * FF * 2 <= WS_END && WS_XB + (size_t)M * D * 2 <= WS_PROJ, "d_ws map");
constexpr int CW_TMO = 0, CW_CODE = 1, CW_BAR = 4096;

constexpr int RING_OFF = 0, RING_BYTES = 131072;
constexpr int LDSCTL_OFF = 143360, MISC_OFF = LDSCTL_OFF + 320;
constexpr int LDS_BYTES = 147456;
__device__ __forceinline__ float wave_sum(float v) {
#pragma unroll
    for (int o = 1; o < 64; o <<= 1) v += __shfl_xor(v, o);
    return v;
}
__device__ __forceinline__ float bf_lo(unsigned u) { return __builtin_bit_cast(float, u << 16); }
__device__ __forceinline__ float bf_hi(unsigned u) { return __builtin_bit_cast(float, u & 0xffff0000u); }
__device__ __forceinline__ float ex2(float x) { return __builtin_amdgcn_exp2f(x); }
__device__ __forceinline__ float lg2(float x) { return __builtin_amdgcn_logf(x); }

__device__ __forceinline__ int rel_bucket(int n) {
    if (n < 16) return n;
    int b = 16;
    b += (n >= 22); b += (n >= 30); b += (n >= 40); b += (n >= 54); b += (n >= 73); b += (n >= 99); b += (n >= 134); b += (n >= 182);
    b += (n >= 246); b += (n >= 332); b += (n >= 450); b += (n >= 609); b += (n >= 825); b += (n >= 1117); b += (n >= 1513);
    return b;
}

__device__ __forceinline__ void p0_transpose_item(const float* W, int K, int N, bf16* WT, const float* g, unsigned qmask, LAS float* scr, int item, int lane) {
    const int nblk = N / 32, kb = item / nblk, nb = item % nblk, k0 = 64 * kb, n0 = 32 * nb;
    const float cs = ((qmask >> (n0 >> 8)) & 1u) ? C2 : 1.0f;
    float wv[32], gv[32];
#pragma unroll
    for (int i = 0; i < 32; ++i) { const int kk = 2 * i + (lane >> 5); wv[i] = W[(size_t)(k0 + kk) * N + n0 + (lane & 31)]; gv[i] = g ? g[k0 + kk] : 1.0f; }
#pragma unroll
    for (int i = 0; i < 32; ++i) { const int kk = 2 * i + (lane >> 5); scr[kk * 33 + (lane & 31)] = wv[i] * (gv[i] * cs); }
    LDS_WAIT(); asm volatile("" ::: "memory");
    const int c = lane & 7;
#pragma unroll
    for (int j = 0; j < 4; ++j) { const int n = (lane >> 3) + 8 * j; const LAS float* s = scr + (8 * c) * 33 + n;
        v4u o; o.x = pk2(s[0 * 33], s[1 * 33]); o.y = pk2(s[2 * 33], s[3 * 33]); o.z = pk2(s[4 * 33], s[5 * 33]); o.w = pk2(s[6 * 33], s[7 * 33]);
        *(v4u*)(WT + (size_t)(n0 + n) * K + k0 + 8 * c) = o; }
    LDS_WAIT(); asm volatile("" ::: "memory");
}

#define FLANE lane_id()
#define FTID (F.wave * 64 + lane_id())
struct Frame {
    LAS unsigned char* lds; char* ldsg;
    volatile LAS unsigned* MISC;
    gu32* ctl;
    int wave, G;
    const float* const* in;
    float* out;
    unsigned char* ws;
};
#define IN_X 0
#define IN_MEM 1
#define IN_REL 2
#define IN_GMIX 3
#define IN_WIN 4
#define IN_GGRP 5
#define IN_SINK 6
#define IN_WOUT 7
#define IN_GCROSS 8
#define IN_GMEM 9
#define IN_WXQ 10
#define IN_WXKV 11
#define IN_WXO 12
#define IN_GMLP 13
#define IN_WUP 14
#define IN_WDOWN 15
#define IN_GFINAL 16

__device__ __forceinline__ void p0_prologue(Frame& F) {
    LAS float* scr = (LAS float*)(F.lds + RING_OFF + F.wave * 16384);
    const int gw = (int)blockIdx.x * NWAVES + F.wave, NGW = F.G * NWAVES;
    constexpr int I_IN = (D / 64) * (INW / 32), I_OUT = (D / 64) * (D / 32), I_XQ = (D / 64) * (XW / 32), I_XKV = (D / 64) * (512 / 32), I_XO = (XW / 64) * (D / 32), I_UP = (D / 64) * (FF / 32), I_DOWN = (FF / 64) * (D / 32);
    constexpr int I_LAYER = I_IN + I_OUT + I_XQ + I_XKV + I_XO + I_UP + I_DOWN;
    {
        bf16* XB = (bf16*)(F.ws + WS_XB); float* ssq = (float*)(F.ws + WS_SSQ);
        constexpr int RB = 4;
        for (int k = 0; ; ++k) {
            const int m0 = gw + k * RB * NGW, it = gw + k * NGW;
            const bool hx = m0 < M, hw = it < DEPTH * I_LAYER;
            if (!hx && !hw) break;
            f32x4 v[RB][4];
            if (hx) {
#pragma unroll
                for (int r = 0; r < RB; ++r) { const f32x4* xr = (const f32x4*)(F.in[IN_X] + (size_t)(m0 + r * NGW) * D) + FLANE;
#pragma unroll
                    for (int j = 0; j < 4; ++j) v[r][j] = xr[64 * j]; }
            }
            if (hw) {
                const int l = it / I_LAYER; int r = it % I_LAYER;
                unsigned char* wl = F.ws + WS_W + (size_t)l * W_LAYER;
                const float* W; int K, N; bf16* WT; const float* g; unsigned qm = 0u;
                if (r < I_IN) { W = F.in[IN_WIN] + (size_t)l * D * INW; K = D; N = INW; WT = (bf16*)(wl + WO_IN); g = F.in[IN_GMIX] + l * D; qm = (1u << 0) | (1u << 3) | (1u << 6) | (1u << 8); }
                else if ((r -= I_IN) < I_OUT) { W = F.in[IN_WOUT] + (size_t)l * D * D; K = D; N = D; WT = (bf16*)(wl + WO_OUT); g = F.in[IN_GGRP] + l * D; }
                else if ((r -= I_OUT) < I_XQ) { W = F.in[IN_WXQ] + (size_t)l * D * XW; K = D; N = XW; WT = (bf16*)(wl + WO_XQ); g = F.in[IN_GCROSS] + l * D; qm = 1u; }
                else if ((r -= I_XQ) < I_XKV) { W = F.in[IN_WXKV] + (size_t)l * D * 512; K = D; N = 512; WT = (bf16*)(F.ws + WS_WXKV) + (size_t)l * 512 * D; g = F.in[IN_GMEM] + l * D; }
                else if ((r -= I_XKV) < I_XO) { W = F.in[IN_WXO] + (size_t)l * XW * D; K = XW; N = D; WT = (bf16*)(wl + WO_XO); g = nullptr; }
                else if ((r -= I_XO) < I_UP) { W = F.in[IN_WUP] + (size_t)l * D * FF; K = D; N = FF; WT = (bf16*)(wl + WO_UP); g = F.in[IN_GMLP] + l * D; }
                else { r -= I_UP; W = F.in[IN_WDOWN] + (size_t)l * FF * D; K = FF; N = D; WT = (bf16*)(wl + WO_DOWN); g = nullptr; }
                p0_transpose_item(W, K, N, WT, g, qm, scr, r, FLANE);
            }
            if (hx) {
#pragma unroll
                for (int r = 0; r < RB; ++r) { const int m = m0 + r * NGW; float s = 0.f;
#pragma unroll
                    for (int j = 0; j < 4; ++j) s += (v[r][j].x * v[r][j].x + v[r][j].y * v[r][j].y) + (v[r][j].z * v[r][j].z + v[r][j].w * v[r][j].w);
                    s = wave_sum(s);
                    unsigned long long* o8 = (unsigned long long*)(XB + (size_t)m * D) + FLANE;
#pragma unroll
                    for (int j = 0; j < 4; ++j) __builtin_nontemporal_store((unsigned long long)pk2(v[r][j].x, v[r][j].y) | ((unsigned long long)pk2(v[r][j].z, v[r][j].w) << 32), o8 + 64 * j);
                    if (FLANE < 16) ssq[(size_t)m * 16 + FLANE] = (FLANE == 0) ? s : 0.f; }
            }
        }
    }
    {
        bf16* MN = (bf16*)(F.ws + WS_MEMN);
        for (int m = gw; m < MROWS; m += NGW) {
            const f32x4* xr = (const f32x4*)(F.in[IN_MEM] + (size_t)m * D) + FLANE;
            f32x4 v[4]; float s = 0.f;
#pragma unroll
            for (int j = 0; j < 4; ++j) { v[j] = xr[64 * j]; s += (v[j].x * v[j].x + v[j].y * v[j].y) + (v[j].z * v[j].z + v[j].w * v[j].w); }
            const float rs = 1.0f / sqrtf(wave_sum(s) * (1.0f / D) + NORM_EPS);
            unsigned long long* o8 = (unsigned long long*)(MN + (size_t)m * D) + FLANE;
#pragma unroll
            for (int j = 0; j < 4; ++j) o8[64 * j] = (unsigned long long)pk2(v[j].x * rs, v[j].y * rs) | ((unsigned long long)pk2(v[j].z * rs, v[j].w * rs) << 32);
        }
    }
    {
        float* bt = (float*)(F.ws + WS_BT);
        for (int i = (int)blockIdx.x * (NWAVES * 64) + FTID; i < 12 * 2049; i += F.G * NWAVES * 64) {
            const int hh = i / 2049, dist = i % 2049;
            bt[hh * BT_STRIDE + dist] = F.in[IN_REL][rel_bucket(dist) * 12 + hh] * LOG2E;
        }
    }
}
namespace att {
using bf16x8 = __attribute__((ext_vector_type(8))) short;
using s16x4 = __attribute__((ext_vector_type(4))) short;
using f32x16 = __attribute__((ext_vector_type(16))) float;
using u32x4 = __attribute__((ext_vector_type(4))) unsigned;
typedef short v4i16_t __attribute__((ext_vector_type(4)));
typedef float f32x2_t __attribute__((ext_vector_type(2))); typedef __bf16 bf16x2_t __attribute__((ext_vector_type(2)));
typedef __attribute__((address_space(3))) const char* lds_cptr;
constexpr int SLOTB = 8192, NSLOT = 4, NSLOT_RES = 6;
constexpr int L_K = 0, L_V = NSLOT_RES * SLOTB, L_WS = 2 * NSLOT_RES * SLOTB, L_OST = L_WS + 8 * 256, L_TBS = L_OST + 8 * 4096, TB_PAD = 128, L_FLG = L_TBS + 2048, L_TBA = L_FLG + 256, L_END = L_TBA + 3 * 2048;
constexpr int L_TBD = L_TBS, L_KM = L_WS, TB_MAXLEN = 2048 + 2 * TB_PAD + 16;
static_assert(L_END <= 143360 && L_TBD + TB_MAXLEN * 4 <= 143360 && L_KM + 2048 <= L_OST && (128 + 2 * TB_PAD + 1) * 4 <= 2048, "attention LDS map");
constexpr float NEGB = -1e30f;
__device__ __forceinline__ int crow(int r, int hi) { return (r & 3) + 8 * (r >> 2) + 4 * hi; }
#define ASBAR() __builtin_amdgcn_sched_barrier(0)
__device__ __forceinline__ void glds16(const void* gsrc, unsigned lds_dst) { unsigned keep;
    asm volatile("s_mov_b32 %0, m0\n\ts_mov_b32 m0, %2\n\ts_nop 0\n\tglobal_load_lds_dwordx4 %1, off\n\ts_mov_b32 m0, %0" : "=&s"(keep) : "v"(gsrc), "s"(lds_dst) : "memory"); }
__device__ __forceinline__ unsigned cvtpk_s(float lo, float hi) { f32x2_t v = {lo, hi}; bf16x2_t b = __builtin_convertvector(v, bf16x2_t); return __builtin_bit_cast(unsigned, b); }
#define AWAIT_BAR(N) asm volatile("s_waitcnt vmcnt(" #N ") lgkmcnt(0)\n\ts_barrier" ::: "memory")
__device__ __forceinline__ float xhalf(float v) { return __shfl_xor(v, 32); }

__device__ __forceinline__ void qkt(f32x16& p0, f32x16& p1, lds_cptr Kslot, const bf16x8* qr, float c0, int r32, int hi) {
    lds_cptr kb = Kslot + hi * 1024 + r32 * 16;
#pragma unroll
    for (int r = 0; r < 16; ++r) { p0[r] = c0; p1[r] = c0; }
#pragma unroll
    for (int d0 = 0; d0 < 4; ++d0) {
        const bf16x8 b0 = *(const __attribute__((address_space(3))) bf16x8*)(kb + d0 * 2048);
        const bf16x8 b1 = *(const __attribute__((address_space(3))) bf16x8*)(kb + d0 * 2048 + 512);
        p0 = __builtin_amdgcn_mfma_f32_32x32x16_bf16(b0, qr[d0], p0, 0, 0, 0); p1 = __builtin_amdgcn_mfma_f32_32x32x16_bf16(b1, qr[d0], p1, 0, 0, 0); }
}
__device__ __forceinline__ s16x4 vtr(lds_cptr p) { return __builtin_bit_cast(s16x4, __builtin_amdgcn_ds_read_tr16_b64_v4i16((__attribute__((address_space(3))) v4i16_t*)p)); }
__device__ __forceinline__ void pv(f32x16* o, lds_cptr vp, const u32x4* pw) {
#pragma unroll
    for (int d0 = 0; d0 < 2; ++d0) {
#pragma unroll
        for (int ks = 0; ks < 4; ++ks) {
            const s16x4 lo = vtr(vp + d0 * 4096 + ks * 1024), hi = vtr(vp + d0 * 4096 + ks * 1024 + 512);
            const bf16x8 vf = (bf16x8){lo[0], lo[1], lo[2], lo[3], hi[0], hi[1], hi[2], hi[3]};
            o[d0] = __builtin_amdgcn_mfma_f32_32x32x16_bf16(__builtin_bit_cast(bf16x8, pw[ks]), vf, o[d0], 0, 0, 0); }
    }
}

__device__ __forceinline__ void kload(bf16x8* kf, lds_cptr Kslot, int r32, int hi) {
    lds_cptr kb = Kslot + r32 * 128;
    const int x = (hi << 4) ^ (((r32 >> 1) & 7) << 4);
#pragma unroll
    for (int d0 = 0; d0 < 4; ++d0) { lds_cptr p = kb + (x ^ (d0 << 5)); kf[2 * d0] = *(const __attribute__((address_space(3))) bf16x8*)(p); kf[2 * d0 + 1] = *(const __attribute__((address_space(3))) bf16x8*)(p + 4096); }
}
__device__ __forceinline__ void vload(s16x4* vlo, s16x4* vhi, lds_cptr vp, lds_cptr vq) {
#pragma unroll
    for (int i = 0; i < 8; ++i) { lds_cptr b = (i >> 2) ? vq : vp; vlo[i] = vtr(b + (i & 3) * 2048); vhi[i] = vtr(b + (i & 3) * 2048 + 1024); }
}
__device__ __forceinline__ int vbase(int lane, int hi, int dh) { const int rl = 4 * hi + ((lane & 15) >> 2); return rl * 128 + ((dh ^ ((rl >> 1) & 1)) << 6) + ((lane >> 4) & 1) * 32 + (lane & 3) * 8; }
__device__ __forceinline__ void qkt_r(f32x16& p0, f32x16& p1, const bf16x8* kf, const bf16x8* qr, float c0) {
#pragma unroll
    for (int r = 0; r < 16; ++r) { p0[r] = c0; p1[r] = c0; }
#pragma unroll
    for (int d0 = 0; d0 < 4; ++d0) { p0 = __builtin_amdgcn_mfma_f32_32x32x16_bf16(kf[2 * d0], qr[d0], p0, 0, 0, 0); p1 = __builtin_amdgcn_mfma_f32_32x32x16_bf16(kf[2 * d0 + 1], qr[d0], p1, 0, 0, 0); }
}
__device__ __forceinline__ void pv_r(f32x16* o, const s16x4* vlo, const s16x4* vhi, const u32x4* pw) {
#pragma unroll
    for (int d0 = 0; d0 < 2; ++d0)
#pragma unroll
        for (int ks = 0; ks < 4; ++ks) { const int i = d0 * 4 + ks;
            const bf16x8 vf = (bf16x8){vlo[i][0], vlo[i][1], vlo[i][2], vlo[i][3], vhi[i][0], vhi[i][1], vhi[i][2], vhi[i][3]};
            o[d0] = __builtin_amdgcn_mfma_f32_32x32x16_bf16(__builtin_bit_cast(bf16x8, pw[ks]), vf, o[d0], 0, 0, 0); }
}
__device__ __forceinline__ void pack_p(u32x4* pw, const f32x16& p0, const f32x16& p1) {
    pw[0] = (u32x4){cvtpk_s(p0[0], p0[1]), cvtpk_s(p0[2], p0[3]), cvtpk_s(p0[4], p0[5]), cvtpk_s(p0[6], p0[7])};
    pw[1] = (u32x4){cvtpk_s(p0[8], p0[9]), cvtpk_s(p0[10], p0[11]), cvtpk_s(p0[12], p0[13]), cvtpk_s(p0[14], p0[15])};
    pw[2] = (u32x4){cvtpk_s(p1[0], p1[1]), cvtpk_s(p1[2], p1[3]), cvtpk_s(p1[4], p1[5]), cvtpk_s(p1[6], p1[7])};
    pw[3] = (u32x4){cvtpk_s(p1[8], p1[9]), cvtpk_s(p1[10], p1[11]), cvtpk_s(p1[12], p1[13]), cvtpk_s(p1[14], p1[15])};
}
__device__ __forceinline__ void build_table(char* shm, int ltb, const float* gt, int dmin, int dmax, int dscale, int tid) {
    float* R = (float*)(shm + ltb); const int OFF = dmax + TB_PAD, len = dmax + 2 * TB_PAD + 1;
    for (int k = tid; k < len; k += 512) { const int dist = OFF - k; R[k] = (dist >= dmin && dist <= dmax) ? gt[dist * dscale] : NEGB; }
}
__device__ __forceinline__ void dma_tile(const bf16* krow0, const bf16* vrow0, long rs, unsigned lds0, int slot, int wid, int lane, int lk = L_K, int lv = L_V) {
    const int krow = 8 * wid + (lane >> 3), kchunk = (lane & 7) ^ ((krow >> 1) & 7);
    const bf16* ksrc = krow0 + (long)krow * rs + kchunk * 8;
    const int vrow = 8 * wid + (lane >> 3), vchunk = (lane & 7) ^ (((vrow >> 1) & 1) << 2);
    const bf16* vsrc = vrow0 + (long)vrow * rs + vchunk * 8;
    glds16(ksrc, (unsigned)__builtin_amdgcn_readfirstlane(lds0 + lk + slot * SLOTB + wid * 1024));
    glds16(vsrc, (unsigned)__builtin_amdgcn_readfirstlane(lds0 + lv + slot * SLOTB + wid * 1024));
}
template <class RowPtr, class SsqPtr> __device__ __forceinline__ void store_o(char* shm, const f32x16* o, const float* rsc  , int wid, int lane, int r32, int hi, const RowPtr& orow, const SsqPtr& ssqp, int lost = L_OST) {
    bf16* stg = (bf16*)(shm + lost) + wid * 2048;
#pragma unroll
    for (int r = 0; r < 16; ++r) { const int q = crow(r, hi);
#pragma unroll
        for (int d0 = 0; d0 < 2; ++d0) stg[q * 64 + d0 * 32 + r32] = (bf16)f2bf(o[d0][r] * rsc[r]); }
    asm volatile("s_waitcnt lgkmcnt(0)" ::: "memory");
#pragma unroll
    for (int i = 0; i < 4; ++i) { const int row = i * 8 + (lane >> 3), ch = lane & 7; const u32x4 v = *(const u32x4*)(stg + row * 64 + ch * 8); *(u32x4*)(orow(row) + ch * 8) = v;
        float* sp = ssqp(row);
        if (sp) { float ss = 0.f;
#pragma unroll
            for (int e = 0; e < 4; ++e) { const float lo = __builtin_bit_cast(float, v[e] << 16), hf = __builtin_bit_cast(float, v[e] & 0xffff0000u); ss += lo * lo + hf * hf; }
            ss += __shfl_xor(ss, 1); ss += __shfl_xor(ss, 2); ss += __shfl_xor(ss, 4);
            if (ch == 0) *sp = ss; } }
}

template <class Pol> __device__ __forceinline__ void unit_issue_kv(const Pol& P, unsigned lds0, int wid, int lane) {
    const int NT = P.ntiles(), T0 = P.first_tile(); const long rs = P.rs();
    if (Pol::RES) {
#pragma nounroll
        for (int t = T0; t < NT; ++t) { const bf16 *kp, *vp; P.tile_ptrs(t, kp, vp); dma_tile(kp, vp, rs, lds0, t - T0, wid, lane); }
    } else if (Pol::PAIR) {
#pragma unroll
      for (int t = 0; t < 4; ++t) { const bf16 *kp, *vp; P.tile_ptrs(T0 + t, kp, vp); dma_tile(kp, vp, rs, lds0, t, wid, lane); }
    } else {
      const bf16 *kp, *vp; P.tile_ptrs(T0, kp, vp); dma_tile(kp, vp, rs, lds0, 0, wid, lane);
      if (T0 + 1 < NT) { P.tile_ptrs(T0 + 1, kp, vp); dma_tile(kp, vp, rs, lds0, 1, wid, lane); } }
}
template <class Pol> __device__ __forceinline__ void unit_issue_q(const Pol& P, unsigned lds0, int wid, int lane) {
#pragma unroll
    for (int j = 0; j < 4; ++j) { const int qrow = 8 * j + (lane >> 3), qch = (lane & 7) ^ ((qrow >> 1) & 7);
        glds16(P.q_row(wid, qrow) + qch * 8, (unsigned)__builtin_amdgcn_readfirstlane(lds0 + L_OST + wid * 4096 + j * 1024)); }
}
template <class Pol, class PolX> __device__ __forceinline__ void softmax_unit(const Pol& P, const Pol& Pn, const bool has_next, const PolX& Px, const bool has_other, const bool pre, bf16x8 (&qn)[4], char* shm, int& tkey, const int wid) {
    const int lane = lane_id(), tid = wid * 64 + lane, r32 = lane & 31, hi = lane >> 5;
    const unsigned lds0 = (unsigned)(uintptr_t)shm;
    float* wsf = (float*)(shm + L_WS) + wid * 64;
    const lds_cptr shm3 = (lds_cptr)shm;
    const lds_cptr vp0 = shm3 + L_V + vbase(lane, hi, 0), vq0 = shm3 + L_V + vbase(lane, hi, 1);
    const int NT = P.ntiles(), T0 = P.first_tile();
    const long rs = P.rs();
    if (!pre) {
        const typename Pol::Pre pr = P.setup_load(tid);
        P.setup_commit(pr, shm, tid, tkey);
        unit_issue_kv(P, lds0, wid, lane);
        unit_issue_q(P, lds0, wid, lane);
    }
    AWAIT_BAR(0);
    bf16x8 qr[4];
    if (pre) {
#pragma unroll
        for (int d0 = 0; d0 < 4; ++d0) qr[d0] = qn[d0];
    } else { lds_cptr qb = shm3 + L_OST + wid * 4096 + r32 * 128; const int x = (hi << 4) ^ (((r32 >> 1) & 7) << 4);
#pragma unroll
      for (int d0 = 0; d0 < 4; ++d0) qr[d0] = *(const __attribute__((address_space(3))) bf16x8*)(qb + (x ^ (d0 << 5))); }
    asm volatile("s_waitcnt lgkmcnt(0)" : "+v"(qr[0]), "+v"(qr[1]), "+v"(qr[2]), "+v"(qr[3]) :: "memory");
    typename Pol::Lane LS; P.prepare(LS, shm, qr, wid, lane, r32, hi);
    float mrun = P.m_init(LS), lrun = P.l_init(LS, hi);
    f32x16 o[2]; o[0] = f32x16{}; o[1] = f32x16{};
    int slot = 0;
    const bool defer = !Pol::RES && !Pol::PAIR && wid >= 4; bool pend = false; int pslot = 0; u32x4 pwp[4];
    bf16x8 kfa[8], kfb[8]; bool havek = false;
    auto tile_body = [&](const int idx, bf16x8* kf, bf16x8* kfn) __attribute__((always_inline)) {
        if (P.uses(LS, idx, wid)) {
            f32x16 p0, p1; s16x4 vlo[8], vhi[8]; float tb0[16], tb1[16];
            if (!(Pol::RES && havek)) kload(kf, shm3 + L_K + slot * SLOTB, r32, hi);
            const bool inited = mrun > -1e29f;
            const float cref = inited ? mrun : 0.f;
            float c0 = P.rowneg(LS, idx) - cref;
            bool tbl = Pol::HAS_TABLE;
            if (Pol::HAS_TABLE) {
                float cb;
                if (P.const_bias(LS, idx, wid, (const float*)(shm + P.ltb()), cb)) { c0 += cb; tbl = false; }
                else {
                    const float* R = (const float*)(shm + P.ltb()) + (P.tb_off() - P.dist0(LS, idx, wid, r32)) + 4 * hi;
#pragma unroll
                    for (int r = 0; r < 16; ++r) { const int c = (r & 3) + 8 * (r >> 2); tb0[r] = R[c]; tb1[r] = R[c + 32]; }
                }
            }
            ASBAR();
            qkt_r(p0, p1, kf, qr, c0);
            ASBAR();
            if (!defer) vload(vlo, vhi, vp0 + slot * SLOTB, vq0 + slot * SLOTB);
            havek = false;
            if (Pol::RES) { if (idx + 1 < NT && P.uses(LS, idx + 1, wid)) { kload(kfn, shm3 + L_K + (slot + 1) * SLOTB, r32, hi); havek = true; } }
            ASBAR();
            if (tbl) {
#pragma unroll
                for (int r = 0; r < 16; ++r) { p0[r] += tb0[r]; p1[r] += tb1[r]; }
            }
            float rm = __builtin_fmaxf(p0[0], p1[0]);
#pragma unroll
            for (int r = 1; r < 16; ++r) rm = __builtin_fmaxf(__builtin_fmaxf(rm, p0[r]), p1[r]);
            rm = __builtin_fmaxf(rm, xhalf(rm));
            const bool need = (rm > 8.0f) || !inited;
            if (__any(need)) {
                const float dl = need ? rm : 0.f;
                const float mnew = cref + dl;
                const float f = need ? ex2(mrun - mnew) : 1.0f;
                mrun = need ? mnew : mrun;
#pragma unroll
                for (int r = 0; r < 16; ++r) { p0[r] -= dl; p1[r] -= dl; }
                lrun *= f;
                if (hi == 0) wsf[r32] = f;
                asm volatile("s_waitcnt lgkmcnt(0)" ::: "memory");
#pragma unroll
                for (int r = 0; r < 16; ++r) { const float fr = wsf[crow(r, hi)]; o[0][r] *= fr; o[1][r] *= fr; }
            }
            float rsum = 0.f;
#pragma unroll
            for (int r = 0; r < 16; ++r) { p0[r] = ex2(p0[r]); p1[r] = ex2(p1[r]); rsum += p0[r] + p1[r]; }
            lrun += rsum;
            u32x4 pw[4]; pack_p(pw, p0, p1);
            if (defer) { pwp[0] = pw[0]; pwp[1] = pw[1]; pwp[2] = pw[2]; pwp[3] = pw[3]; pslot = slot; pend = true; }
            else pv_r(o, vlo, vhi, pw);
        }
    };
    if (Pol::RES) {
        for (int idx = T0; idx < NT; idx += 2) {
            tile_body(idx, kfa, kfb); ++slot;
            if (idx + 1 < NT) { tile_body(idx + 1, kfb, kfa); ++slot; }
        }
    } else {
    for (int idx = T0; idx < NT; ++idx) {
        if (!Pol::RES) {
            if (Pol::PAIR) {
                if (((idx - T0) & 1) == 0) {
                    if (idx + 2 < NT) { AWAIT_BAR(4); } else { AWAIT_BAR(0); }
                    if (idx + 4 < NT) { const bf16 *kp, *vp; const int s4 = slot + 4 >= 6 ? slot - 2 : slot + 4;
                                        P.tile_ptrs(idx + 4, kp, vp); dma_tile(kp, vp, rs, lds0, s4, wid, lane);
                                        P.tile_ptrs(idx + 5, kp, vp); dma_tile(kp, vp, rs, lds0, s4 + 1, wid, lane); }
                }
            } else {
                if (idx + 1 < NT) { AWAIT_BAR(2); } else { AWAIT_BAR(0); }
                if (idx + 2 < NT) { const bf16 *kp, *vp; P.tile_ptrs(idx + 2, kp, vp); dma_tile(kp, vp, rs, lds0, (slot + 2) & 3, wid, lane); }
            }
        }
        if (pend) { s16x4 vlo[8], vhi[8]; vload(vlo, vhi, vp0 + pslot * SLOTB, vq0 + pslot * SLOTB); pv_r(o, vlo, vhi, pwp); pend = false; }
        tile_body(idx, kfa, kfb);
        slot = Pol::PAIR ? (slot + 1 == 6 ? 0 : slot + 1) : ((slot + 1) & 3);
    }
    }
    if (pend) { s16x4 vlo[8], vhi[8]; vload(vlo, vhi, vp0 + pslot * SLOTB, vq0 + pslot * SLOTB); pv_r(o, vlo, vhi, pwp); }
    lrun += xhalf(lrun);
    P.finish(LS, mrun, lrun, wid, r32, hi);
    if (hi == 0) wsf[32 + r32] = 1.0f / lrun;
    asm volatile("s_waitcnt lgkmcnt(0)" ::: "memory");
    float rli[16];
#pragma unroll
    for (int r = 0; r < 16; ++r) rli[r] = wsf[32 + crow(r, hi)];
    if (has_next) {
#pragma unroll
        for (int d0 = 0; d0 < 4; ++d0) qn[d0] = *(const bf16x8*)(Pn.q_row(wid, r32) + d0 * 16 + hi * 8);
        const typename Pol::Pre pr = Pn.setup_load(tid);
        asm volatile("s_waitcnt lgkmcnt(0)\n\ts_barrier" ::: "memory");
        Pn.setup_commit(pr, shm, tid, tkey);
        unit_issue_kv(Pn, lds0, wid, lane);
    } else if (has_other) {
#pragma unroll
        for (int d0 = 0; d0 < 4; ++d0) qn[d0] = *(const bf16x8*)(Px.q_row(wid, r32) + d0 * 16 + hi * 8);
        const typename PolX::Pre pr = Px.setup_load(tid);
        asm volatile("s_waitcnt lgkmcnt(0)\n\ts_barrier" ::: "memory");
        Px.setup_commit(pr, shm, tid, tkey);
        unit_issue_kv(Px, lds0, wid, lane);
    }
    store_o(shm, o, rli, wid, lane, r32, hi, [&](int row) { return P.o_row(wid, row); }, [&](int row) { return P.ssq_row(wid, row); });
    if (!has_next && !has_other) {
        asm volatile("s_waitcnt lgkmcnt(0)\n\ts_barrier" ::: "memory");
    }
}

struct LaneNone {};
struct PolD {
    static constexpr bool HAS_TABLE = true, RES = false, PAIR = true; static constexpr int LTB = L_TBD;
    struct Lane { unsigned sel, wavesel; };
    const bf16* proj; bf16* Y; const float* bt; const float* kmean; int b, h, qb;
    __device__ __forceinline__ int ntiles() const { return 4 * (qb + 1); }
    __device__ __forceinline__ int first_tile() const { return 0; }
    __device__ __forceinline__ long rs() const { return INW; }
    __device__ __forceinline__ int tb_off() const { return 2047 + TB_PAD; }
    struct Pre { float kmv; };
    __device__ __forceinline__ int ltb() const { return LTB; }
    __device__ __forceinline__ Pre setup_load(int tid) const {
        const float* kp = kmean + ((size_t)(b * 8 + (tid >> 6)) * 2) * 256 + h * 64 + (tid & 63); return Pre{(kp[0] + kp[256]) * (1.0f / 256.0f)}; }
    __device__ __forceinline__ void setup_commit(const Pre& pr, char* shm, int tid, int& tkey) const {
        if (tkey != 100 + h) { build_table(shm, LTB, bt + (8 + h) * BT_STRIDE, 0, 2047, 1, tid); tkey = 100 + h; }
        float* km = (float*)(shm + L_KM); km[tid] = pr.kmv;
    }
    __device__ __forceinline__ const bf16* q_row(int wid, int r32) const { return proj + ((size_t)b * SEQ + qb * 256 + wid * 32 + r32) * INW + COL_DQ + h * 64; }
    __device__ __forceinline__ bf16* o_row(int wid, int row) const { return Y + ((size_t)b * SEQ + qb * 256 + wid * 32 + row) * D + 768 + h * 64; }
    float* ssqy; __device__ __forceinline__ float* ssq_row(int wid, int row) const { return ssqy + ((size_t)b * SEQ + qb * 256 + wid * 32 + row) * 16 + 12 + h; }
    __device__ __forceinline__ void tile_ptrs(int idx, const bf16*& kp, const bf16*& vp) const { const bf16* r0 = proj + ((size_t)b * SEQ + idx * 64) * INW + h * 64; kp = r0 + COL_DK; vp = r0 + COL_DV; }
    __device__ __forceinline__ void prepare(Lane& L, char* shm, const bf16x8* qr, int wid, int lane, int r32, int hi) const {
        const float* km = (const float*)(shm + L_KM);
        float gate[8];
#pragma unroll
        for (int n = 0; n < 8; ++n) { float s = 0.f;
            if (n < qb) {
#pragma unroll
                for (int d0 = 0; d0 < 4; ++d0)
#pragma unroll
                    for (int e = 0; e < 8; ++e) s += __builtin_bit_cast(float, (unsigned)(unsigned short)qr[d0][e] << 16) * km[n * 64 + d0 * 16 + hi * 8 + e];
                s += xhalf(s);
            }
            gate[n] = (n < qb) ? s : -3e38f; }
        unsigned sel = 0u;
#pragma unroll
        for (int n = 0; n < 8; ++n) { int rank = 0;
#pragma unroll
            for (int n2 = 0; n2 < 8; ++n2) rank += (n2 != n) && ((gate[n2] > gate[n]) || (gate[n2] == gate[n] && n2 < n));
            if (n < qb && rank < 3) sel |= 1u << n; }
        unsigned ws = 0u;
#pragma unroll
        for (int n = 0; n < 8; ++n) ws |= (__ballot((sel >> n) & 1u) != 0ull) ? (1u << n) : 0u;
        L.sel = sel; L.wavesel = ws;
    }
    __device__ __forceinline__ bool uses(const Lane& L, int idx, int wid) const { const int blk = idx >> 2; return blk == qb ? ((idx & 3) * 64 <= wid * 32 + 31) : ((L.wavesel >> blk) & 1u); }
    __device__ __forceinline__ float rowneg(const Lane& L, int idx) const { const int blk = idx >> 2; return (blk == qb || ((L.sel >> blk) & 1u)) ? 0.f : NEGB; }
    __device__ __forceinline__ bool const_bias(const Lane&, int idx, int wid, const float* R, float& cb) const {
        const int dlo = qb * 256 + wid * 32 - idx * 64 - 63;
        const unsigned d = (unsigned)dlo;
        const bool one = (d - 332u <= 23u) | (d - 450u <= 64u) | (d - 609u <= 121u) | (d - 825u <= 197u) | (d - 1117u <= 301u) | (dlo >= 1513);
        if ((idx >> 2) >= qb || dlo < 16 || !one) return false;
        cb = R[tb_off() - dlo]; return true; }
    __device__ __forceinline__ int dist0(const Lane&, int idx, int wid, int r32) const { return qb * 256 + wid * 32 + r32 - idx * 64; }
    __device__ __forceinline__ float m_init(const Lane&) const { return NEGB; }
    __device__ __forceinline__ float l_init(const Lane&, int) const { return 0.f; }
    __device__ __forceinline__ void finish(const Lane&, float, float, int, int, int) const {}
};

struct PolX {
    static constexpr bool HAS_TABLE = false, RES = true, PAIR = false; static constexpr int LTB = L_TBS;
    struct Lane {};
    const bf16* Q2; bf16* O2; const bf16* KV; int l, b, h, s;
    __device__ __forceinline__ int ntiles() const { return 4; }
    __device__ __forceinline__ int first_tile() const { return 0; }
    __device__ __forceinline__ long rs() const { return 1024; }
    __device__ __forceinline__ int tb_off() const { return 0; }
    struct Pre {}; __device__ __forceinline__ int ltb() const { return LTB; }
    __device__ __forceinline__ Pre setup_load(int) const { return Pre{}; }
    __device__ __forceinline__ void setup_commit(const Pre&, char*, int, int&) const {}
    __device__ __forceinline__ const bf16* q_row(int wid, int r32) const { return Q2 + ((size_t)b * SEQ + s * 256 + wid * 32 + r32) * XW + h * 64; }
    __device__ __forceinline__ bf16* o_row(int wid, int row) const { return O2 + ((size_t)b * SEQ + s * 256 + wid * 32 + row) * XW + h * 64; }
    __device__ __forceinline__ float* ssq_row(int, int) const { return nullptr; }
    __device__ __forceinline__ void tile_ptrs(int idx, const bf16*& kp, const bf16*& vp) const { kp = KV + ((size_t)b * MEMLEN + idx * 64) * 1024 + l * 512 + h * 64; vp = kp + 256; }
    __device__ __forceinline__ void prepare(Lane&, char*, const bf16x8*, int, int, int, int) const {}
    __device__ __forceinline__ bool uses(const Lane&, int, int) const { return true; }
    __device__ __forceinline__ float rowneg(const Lane&, int) const { return 0.f; }
    __device__ __forceinline__ bool const_bias(const Lane&, int, int, const float*, float&) const { return false; }
    __device__ __forceinline__ int dist0(const Lane&, int, int, int) const { return 0; }
    __device__ __forceinline__ float m_init(const Lane&) const { return NEGB; }
    __device__ __forceinline__ float l_init(const Lane&, int) const { return 0.f; }
    __device__ __forceinline__ void finish(const Lane&, float, float, int, int, int) const {}
};
struct PolC {
    static constexpr bool HAS_TABLE = true, RES = true, PAIR = false; static constexpr int LTB = L_TBS;
    struct Lane {};
    const bf16* proj; bf16* Y; const float* bt; float sink2; int b, h, s;
    __device__ __forceinline__ int ntiles() const { return 6; }
    __device__ __forceinline__ int first_tile() const { return s == 0 ? 2 : 0; }
    __device__ __forceinline__ long rs() const { return INW; }
    __device__ __forceinline__ int tb_off() const { return 127 + TB_PAD; }
    struct Pre {}; __device__ __forceinline__ int ltb() const { return LTB; }
    __device__ __forceinline__ Pre setup_load(int) const { return Pre{}; }
    __device__ __forceinline__ void setup_commit(const Pre&, char* shm, int tid, int& tkey) const { if (tkey != 300 + h) { build_table(shm, LTB, bt + (4 + h) * BT_STRIDE, 0, 127, 1, tid); tkey = 300 + h; } }
    __device__ __forceinline__ const bf16* q_row(int wid, int r32) const { return proj + ((size_t)b * SEQ + s * 256 + wid * 32 + r32) * INW + COL_CQ + h * 64; }
    __device__ __forceinline__ bf16* o_row(int wid, int row) const { return Y + ((size_t)b * SEQ + s * 256 + wid * 32 + row) * D + 512 + h * 64; }
    float* ssqy; __device__ __forceinline__ float* ssq_row(int wid, int row) const { return ssqy + ((size_t)b * SEQ + s * 256 + wid * 32 + row) * 16 + 8 + h; }
    __device__ __forceinline__ void tile_ptrs(int idx, const bf16*& kp, const bf16*& vp) const { const bf16* r0 = proj + ((size_t)b * SEQ + s * 256 - 128 + idx * 64) * INW + (h >> 1) * 64; kp = r0 + COL_CK; vp = r0 + COL_CV; }
    __device__ __forceinline__ void prepare(Lane&, char*, const bf16x8*, int, int, int, int) const {}
    __device__ __forceinline__ bool uses(const Lane&, int idx, int wid) const { const int iw = 128 + 32 * wid, j0 = 64 * idx; return j0 <= iw + 31 && j0 + 63 >= iw - 127; }
    __device__ __forceinline__ float rowneg(const Lane&, int) const { return 0.f; }
    __device__ __forceinline__ bool const_bias(const Lane&, int, int, const float*, float&) const { return false; }
    __device__ __forceinline__ int dist0(const Lane&, int idx, int wid, int r32) const { return 128 + 32 * wid + r32 - 64 * idx; }
    __device__ __forceinline__ float m_init(const Lane&) const { return sink2; }
    __device__ __forceinline__ float l_init(const Lane&, int hi) const { return hi == 0 ? 1.0f : 0.f; }
    __device__ __forceinline__ void finish(const Lane&, float, float, int, int, int) const {}
};
struct PolA {
    static constexpr bool HAS_TABLE = true, RES = true, PAIR = false; static constexpr int LTB = L_TBS;
    struct Lane {};
    const bf16* proj; bf16* Y; bf16* YA1; bf16* YA2; float* lse; const float* bt; int b, h, cfg, sub;
    __device__ __forceinline__ int dil() const { return cfg == 0 ? 1 : (cfg == 1 ? 4 : 16); }
    __device__ __forceinline__ int ntiles() const { return cfg == 2 ? 4 : 6; }
    __device__ __forceinline__ int first_tile() const { return cfg == 2 ? 0 : (((cfg == 0 ? sub : (sub & 1)) == 0) ? 2 : 0); }
    __device__ __forceinline__ long rs() const { return (long)dil() * INW; }
    __device__ __forceinline__ int tb_off() const { return 128 + TB_PAD; }
    struct Pre {}; __device__ __forceinline__ int ltb() const { return L_TBA + cfg * 2048; }
    __device__ __forceinline__ Pre setup_load(int) const { return Pre{}; }
    __device__ __forceinline__ void setup_commit(const Pre&, char* shm, int tid, int& tkey) const {
        if (tkey != 200 + h) { build_table(shm, L_TBA, bt + h * BT_STRIDE, 0, 128, 1, tid); build_table(shm, L_TBA + 2048, bt + h * BT_STRIDE, 0, 128, 4, tid);
                               build_table(shm, L_TBA + 4096, bt + h * BT_STRIDE, 0, 128, 16, tid); tkey = 200 + h; } }
    __device__ __forceinline__ int token(int wid, int r) const {
        if (cfg == 0) return sub * 256 + wid * 32 + r;
        if (cfg == 1) return (sub >> 1) + 4 * ((sub & 1) * 256 + wid * 32 + r);
        return (2 * sub + (wid >> 2)) + 16 * ((wid & 3) * 32 + r);
    }
    __device__ __forceinline__ const bf16* q_row(int wid, int r32) const { return proj + ((size_t)b * SEQ + token(wid, r32)) * INW + COL_AQ + h * 64; }
    __device__ __forceinline__ bf16* o_row(int wid, int row) const { const size_t t = (size_t)b * SEQ + token(wid, row);
        return cfg == 0 ? Y + t * D + h * 64 : (cfg == 1 ? YA1 : YA2) + t * 256 + h * 64; }
    __device__ __forceinline__ float* ssq_row(int, int) const { return nullptr; }
    __device__ __forceinline__ void tile_ptrs(int idx, const bf16*& kp, const bf16*& vp) const {
        int t0;
        if (cfg == 0) t0 = sub * 256 - 128 + idx * 64;
        else if (cfg == 1) t0 = (sub >> 1) + 4 * ((sub & 1) * 256 - 128 + idx * 64);
        else t0 = (2 * sub + (idx >> 1)) + 16 * ((idx & 1) * 64);
        const bf16* r0 = proj + ((size_t)b * SEQ + t0) * INW + h * 64; kp = r0 + COL_AK; vp = r0 + COL_AV; }
    __device__ __forceinline__ void prepare(Lane&, char*, const bf16x8*, int, int, int, int) const {}
    __device__ __forceinline__ bool uses(const Lane&, int idx, int wid) const {
        if (cfg == 2) return (idx >> 1) == (wid >> 2) && 64 * (idx & 1) <= 32 * (wid & 3) + 31;
        const int iw = 128 + 32 * wid, j0 = 64 * idx; return j0 <= iw + 31 && j0 + 63 >= iw - 128; }
    __device__ __forceinline__ float rowneg(const Lane&, int) const { return 0.f; }
    __device__ __forceinline__ bool const_bias(const Lane&, int, int, const float*, float&) const { return false; }
    __device__ __forceinline__ int dist0(const Lane&, int idx, int wid, int r32) const { return cfg == 2 ? (32 * (wid & 3) + r32 - 64 * (idx & 1)) : (128 + 32 * wid + r32 - 64 * idx); }
    __device__ __forceinline__ float m_init(const Lane&) const { return NEGB; }
    __device__ __forceinline__ float l_init(const Lane&, int) const { return 0.f; }
    __device__ __forceinline__ void finish(const Lane&, float m, float l, int wid, int r32, int hi) const {
        if (hi == 0) lse[((size_t)cfg * M + (size_t)b * SEQ + token(wid, r32)) * 4 + h] = m + lg2(l); }
};

struct PolNone {
    static constexpr bool RES = true, PAIR = false; struct Pre {};
    __device__ __forceinline__ int ntiles() const { return 0; }
    __device__ __forceinline__ int first_tile() const { return 0; }
    __device__ __forceinline__ long rs() const { return 0; }
    __device__ __forceinline__ void tile_ptrs(int, const bf16*& kp, const bf16*& vp) const { kp = nullptr; vp = nullptr; }
    __device__ __forceinline__ const bf16* q_row(int, int) const { return nullptr; }
    __device__ __forceinline__ Pre setup_load(int) const { return Pre{}; }
    __device__ __forceinline__ void setup_commit(const Pre&, char*, int, int&) const {}
};
struct PolSBNext {
    static constexpr bool RES = true, PAIR = false; struct Pre {};
    const bf16* proj; int b, h, s;
    __device__ __forceinline__ int ntiles() const { const int NT = 4 * s + 4; return NT < 6 ? NT : 6; }
    __device__ __forceinline__ int first_tile() const { return 0; }
    __device__ __forceinline__ long rs() const { return INW; }
    __device__ __forceinline__ void tile_ptrs(int k, const bf16*& kp, const bf16*& vp) const { const bf16* r0 = proj + ((size_t)b * SEQ + (size_t)(4 * s + 3 - k) * 64) * INW + h * 64; kp = r0 + COL_BK; vp = r0 + COL_BV; }
    __device__ __forceinline__ const bf16* q_row(int wid, int r32) const { return proj + ((size_t)b * SEQ + s * 256 + wid * 32 + r32) * INW + COL_BQ + h * 64; }
    __device__ __forceinline__ Pre setup_load(int) const { return Pre{}; }
    __device__ __forceinline__ void setup_commit(const Pre&, char*, int, int&) const {}
};

constexpr int SB_NR = 6, SB_LK = 0, SB_LV = SB_NR * SLOTB, SB_END = 2 * SB_NR * SLOTB;
static_assert(SB_NR == 6 && SB_LK == L_K && SB_LV == L_V, "PolSBNext requests the first unit's tiles through the resident-mode slot map");
static_assert(SB_END <= L_WS, "stick-breaking LDS map");
__device__ __forceinline__ void sb_unit(const bf16* proj, bf16* Y, float* ssqy, int b, int h, int s, int nb, int ns, const bool has_next, const bool pre, bf16x8 (&qn)[4], char* shm, const int wid) {
    const int lane = lane_id(), tid = wid * 64 + lane, r32 = lane & 31, hi = lane >> 5;
    const unsigned lds0 = (unsigned)(uintptr_t)shm;
    const lds_cptr shm3 = (lds_cptr)shm;
    const lds_cptr vp0 = shm3 + SB_LV + vbase(lane, hi, 0), vq0 = shm3 + SB_LV + vbase(lane, hi, 1);
    __attribute__((address_space(3))) unsigned* flg = (__attribute__((address_space(3))) unsigned*)(shm3 + L_FLG);
    const int NT = 4 * s + 4, NR = NT < SB_NR ? NT : SB_NR;
    const bf16* kbase = proj + (size_t)b * SEQ * INW + COL_BK + h * 64; const bf16* vbase = proj + (size_t)b * SEQ * INW + COL_BV + h * 64;
#define SB_TILE(idx) (4 * s + 3 - (idx))
#define SB_DMA(idx, slot) dma_tile(kbase + (size_t)SB_TILE(idx) * 64 * INW, vbase + (size_t)SB_TILE(idx) * 64 * INW, INW, lds0, (slot), wid, lane, SB_LK, SB_LV)
    bf16x8 qr[4];
    if (!pre) {
#pragma nounroll
        for (int k = 0; k < NR; ++k) SB_DMA(k, k);
        const bf16* Qrow = proj + ((size_t)b * SEQ + s * 256 + wid * 32 + r32) * INW + COL_BQ + h * 64;
#pragma unroll
        for (int d0 = 0; d0 < 4; ++d0) qr[d0] = *(const bf16x8*)(Qrow + d0 * 16 + hi * 8);
    } else {
#pragma unroll
        for (int d0 = 0; d0 < 4; ++d0) qr[d0] = qn[d0];
    }
    AWAIT_BAR(0);
    asm volatile("" : "+v"(qr[0]), "+v"(qr[1]), "+v"(qr[2]), "+v"(qr[3]));
    float carry = 1.0f; f32x16 o[2]; o[0] = f32x16{}; o[1] = f32x16{};
    const int iq = s * 256 + wid * 32 + r32;
    bool wdone = false;
#define SB_COMPUTE(slot_, j0_) do { \
        f32x16 p0, p1; bf16x8 kf[8]; s16x4 vlo[8], vhi[8]; \
        kload(kf, shm3 + SB_LK + (slot_) * SLOTB, r32, hi); \
        ASBAR(); \
        qkt_r(p0, p1, kf, qr, 0.f); \
        ASBAR(); \
        vload(vlo, vhi, vp0 + (slot_) * SLOTB, vq0 + (slot_) * SLOTB); \
        ASBAR(); \
        const bool diag = ((j0_) + 63 >= s * 256 + wid * 32); \
        const int dist0 = iq - (j0_) - 4 * hi; \
        if (diag) { _Pragma("unroll") for (int r = 0; r < 16; ++r) { const int c = (r & 3) + 8 * (r >> 2); if (dist0 - c < 1) p0[r] = -1e30f; if (dist0 - c - 32 < 1) p1[r] = -1e30f; } } \
          \
          \
        f32x2_t rr[16]; \
        _Pragma("unroll") for (int r = 0; r < 16; ++r) { f32x2_t w_ = (f32x2_t){ex2(p0[r]), ex2(p1[r])} + 1.0f; rr[r] = (f32x2_t){__builtin_amdgcn_rcpf(w_.x), __builtin_amdgcn_rcpf(w_.y)}; } \
        f32x2_t gsv[4], pgv[4]; \
        _Pragma("unroll") for (int g = 0; g < 4; ++g) gsv[g] = (rr[4 * g] * rr[4 * g + 1]) * (rr[4 * g + 2] * rr[4 * g + 3]); \
        _Pragma("unroll") for (int g = 0; g < 4; ++g) pgv[g] = (f32x2_t){xhalf(gsv[g].x), xhalf(gsv[g].y)}; \
          \
        float T[8]; float run = carry; \
        _Pragma("unroll") for (int g = 7; g >= 0; --g) { const float gsg = g >= 4 ? gsv[g & 3].y : gsv[g & 3].x, pgg = g >= 4 ? pgv[g & 3].y : pgv[g & 3].x; T[g] = hi == 0 ? run * pgg : run; run *= gsg * pgg; } \
          \
        f32x2_t a2[16]; \
        _Pragma("unroll") for (int g = 0; g < 4; ++g) { f32x2_t S = (f32x2_t){T[g], T[4 + g]}; \
            _Pragma("unroll") for (int i = 3; i >= 0; --i) { const f32x2_t Sn = S * rr[4 * g + i]; a2[4 * g + i] = S - Sn; S = Sn; } } \
        carry = run; \
        u32x4 pw[4]; \
        _Pragma("unroll") for (int q_ = 0; q_ < 2; ++q_) _Pragma("unroll") for (int e_ = 0; e_ < 4; ++e_) { \
            pw[q_][e_] = cvtpk_s(a2[8 * q_ + 2 * e_].x, a2[8 * q_ + 2 * e_ + 1].x); pw[2 + q_][e_] = cvtpk_s(a2[8 * q_ + 2 * e_].y, a2[8 * q_ + 2 * e_ + 1].y); } \
        pv_r(o, vlo, vhi, pw); \
        wdone = __all(carry < 0x1p-48f); \
    } while (0)
#pragma nounroll
    for (int k = 0; k < NR; ++k) {
        const int j0 = SB_TILE(k) * 64;
        if (!wdone && j0 < s * 256 + wid * 32 + 31) SB_COMPUTE(k, j0);
    }
    if (NT > NR) {
        if (lane == 0) flg[16 + wid] = wdone ? 1u : 0u;
        asm volatile("s_waitcnt lgkmcnt(0)\n\ts_barrier" ::: "memory");
        const unsigned alld = flg[16] & flg[17] & flg[18] & flg[19] & flg[20] & flg[21] & flg[22] & flg[23];
        if (!__builtin_amdgcn_readfirstlane(alld)) {
            SB_DMA(NR, 0);
            if (NR + 1 < NT) SB_DMA(NR + 1, 1);
            int slot = 0;
            for (int idx = NR; idx < NT; ++idx) {
                if (idx + 1 < NT) { AWAIT_BAR(2); } else { AWAIT_BAR(0); }
                if (idx > NR) { const __attribute__((address_space(3))) unsigned* f = flg + ((idx - 1) & 1) * 8; unsigned all = f[0] & f[1] & f[2] & f[3] & f[4] & f[5] & f[6] & f[7]; if (__builtin_amdgcn_readfirstlane(all)) break; }
                if (idx + 2 < NT) SB_DMA(idx + 2, (slot + 2) & 3);
                const int j0 = SB_TILE(idx) * 64;
                if (!wdone) SB_COMPUTE(slot, j0);
                if (lane == 0) flg[(idx & 1) * 8 + wid] = wdone ? 1u : 0u;
                slot = (slot + 1) & 3;
            }
            asm volatile("s_waitcnt vmcnt(0)" ::: "memory");
        }
    }
#undef SB_COMPUTE
#undef SB_DMA
#undef SB_TILE
    if (has_next) {
        const bf16* Qrow = proj + ((size_t)nb * SEQ + ns * 256 + wid * 32 + r32) * INW + COL_BQ + h * 64;
#pragma unroll
        for (int d0 = 0; d0 < 4; ++d0) qn[d0] = *(const bf16x8*)(Qrow + d0 * 16 + hi * 8);
    }
    asm volatile("s_waitcnt lgkmcnt(0)\n\ts_barrier" ::: "memory");
    if (has_next) {
        const int nNT = 4 * ns + 4, nNR = nNT < SB_NR ? nNT : SB_NR;
        const bf16* nk = proj + (size_t)nb * SEQ * INW + COL_BK + h * 64; const bf16* nv = proj + (size_t)nb * SEQ * INW + COL_BV + h * 64;
#pragma nounroll
        for (int k = 0; k < nNR; ++k) dma_tile(nk + (size_t)(4 * ns + 3 - k) * 64 * INW, nv + (size_t)(4 * ns + 3 - k) * 64 * INW, INW, lds0, k, wid, lane, SB_LK, SB_LV);
    }
    float one[16];
#pragma unroll
    for (int r = 0; r < 16; ++r) one[r] = 1.0f;
    store_o(shm, o, one, wid, lane, r32, hi, [&](int row) { return Y + ((size_t)b * SEQ + s * 256 + wid * 32 + row) * D + 256 + h * 64; },
            [&](int row) { return ssqy + ((size_t)b * SEQ + s * 256 + wid * 32 + row) * 16 + 4 + h; });
    if (!has_next) { asm volatile("s_waitcnt lgkmcnt(0)\n\ts_barrier" ::: "memory"); }
}
}
__device__ __forceinline__ void nm_merge(Frame& F) {
    bf16* Y = (bf16*)(F.ws + WS_Y); const bf16* YA1 = (const bf16*)(F.ws + WS_YA1); const bf16* YA2 = (const bf16*)(F.ws + WS_YA2); const float* lse = (const float*)(F.ws + WS_LSE);
    const float* ssqy = (const float*)(F.ws + WS_SSQY); float* rat = (float*)(F.ws + WS_RAT);
    const int gw = (int)blockIdx.x * NWAVES + F.wave, NGW = F.G * NWAVES;
    constexpr int RB = 4;
    for (int row0 = gw; row0 < M; row0 += RB * NGW) {
        unsigned long long w[RB], wa[RB], wc[RB]; float l0[RB], l1[RB], l2[RB], pp[RB];
#pragma unroll
        for (int j = 0; j < RB; ++j) { const int row = row0 + j * NGW;
            w[j] = *((const unsigned long long*)(Y + (size_t)row * D) + FLANE);
            const int hh = FLANE >> 4;
            l0[j] = lse[(size_t)row * 4 + hh]; l1[j] = lse[(size_t)(M + row) * 4 + hh]; l2[j] = lse[(size_t)(2 * M + row) * 4 + hh];
            wa[j] = *((const unsigned long long*)(YA1 + (size_t)row * 256) + FLANE); wc[j] = *((const unsigned long long*)(YA2 + (size_t)row * 256) + FLANE);
            pp[j] = ssqy[(size_t)row * 16 + (FLANE & 15)];
        }
#pragma unroll
        for (int j = 0; j < RB; ++j) { const int row = row0 + j * NGW;
            const unsigned long long ww = w[j];
            float v0 = bf_lo((unsigned)ww), v1 = bf_hi((unsigned)ww), v2 = bf_lo((unsigned)(ww >> 32)), v3 = bf_hi((unsigned)(ww >> 32));
            const float mx = __builtin_fmaxf(l0[j], __builtin_fmaxf(l1[j], l2[j]));
            const float w0 = ex2(l0[j] - mx), w1 = ex2(l1[j] - mx), w2 = ex2(l2[j] - mx), inv = 1.0f / (w0 + w1 + w2);
            const unsigned long long a = wa[j], c = wc[j];
            v0 = (w0 * v0 + w1 * bf_lo((unsigned)a) + w2 * bf_lo((unsigned)c)) * inv; v1 = (w0 * v1 + w1 * bf_hi((unsigned)a) + w2 * bf_hi((unsigned)c)) * inv;
            v2 = (w0 * v2 + w1 * bf_lo((unsigned)(a >> 32)) + w2 * bf_lo((unsigned)(c >> 32))) * inv; v3 = (w0 * v3 + w1 * bf_hi((unsigned)(a >> 32)) + w2 * bf_hi((unsigned)(c >> 32))) * inv;
            const unsigned p01 = pk2(v0, v1), p23 = pk2(v2, v3);
            *((unsigned long long*)(Y + (size_t)row * D) + FLANE) = (unsigned long long)p01 | ((unsigned long long)p23 << 32);
            const float r0 = bf_lo(p01), r1 = bf_hi(p01), r2 = bf_lo(p23), r3 = bf_hi(p23);
            const float ssA = wave_sum((r0 * r0 + r1 * r1) + (r2 * r2 + r3 * r3));
            float sg = pp[j]; sg += __shfl_xor(sg, 1); sg += __shfl_xor(sg, 2);
            const float ssB = __shfl(sg, 4), ssC = __shfl(sg, 8), ssD = __shfl(sg, 12);
            const float sA = 1.0f / sqrtf(ssA * (1.0f / 256.0f) + NORM_EPS), sB = 1.0f / sqrtf(ssB * (1.0f / 256.0f) + NORM_EPS);
            const float sC = 1.0f / sqrtf(ssC * (1.0f / 256.0f) + NORM_EPS), sD = 1.0f / sqrtf(ssD * (1.0f / 256.0f) + NORM_EPS);
            if (FLANE == 0) *(f32x4*)(rat + (size_t)row * 4) = f32x4{sA / sB, sB / sC, sC / sD, sD};
        }
    }
}
__device__ __forceinline__ void fn_finalnorm(Frame& F, const float* ssq) {
    const int gw = (int)blockIdx.x * NWAVES + F.wave, NGW = F.G * NWAVES;
    const f32x4* gf = (const f32x4*)F.in[IN_GFINAL] + FLANE;
    const bf16* XB = (const bf16*)(F.ws + WS_XB);
    f32x4 gv[4];
#pragma unroll
    for (int j = 0; j < 4; ++j) gv[j] = gf[64 * j];
    constexpr int RB = 4;
    for (int row0 = gw; row0 < M; row0 += RB * NGW) {
        unsigned long long w[RB][4]; float s[RB];
#pragma unroll
        for (int r = 0; r < RB; ++r) { const int row = row0 + r * NGW;
            s[r] = (FLANE < 16) ? ssq[(size_t)row * 16 + FLANE] : 0.f;
            const unsigned long long* xr = (const unsigned long long*)(XB + (size_t)row * D) + FLANE;
#pragma unroll
            for (int j = 0; j < 4; ++j) w[r][j] = xr[64 * j]; }
#pragma unroll
        for (int r = 0; r < RB; ++r) { const int row = row0 + r * NGW;
            const float rs = 1.0f / sqrtf(wave_sum(s[r]) * (1.0f / D) + NORM_EPS);
            f32x4* orow = (f32x4*)(F.out + (size_t)row * D) + FLANE;
#pragma unroll
            for (int j = 0; j < 4; ++j) { const unsigned long long ww = w[r][j];
                f32x4 v = {bf_lo((unsigned)ww), bf_hi((unsigned)ww), bf_lo((unsigned)(ww >> 32)), bf_hi((unsigned)(ww >> 32))};
                __builtin_nontemporal_store(v * rs * gv[j], orow + 64 * j); } }
    }
}
__device__ __forceinline__ void at_phase(Frame& F, int l) {
    const bf16* proj = (const bf16*)(F.ws + WS_PROJ); bf16* Y = (bf16*)(F.ws + WS_Y); const float* bt = (const float*)(F.ws + WS_BT); const float* kmean = (const float*)(F.ws + WS_KMEAN);
    const float* sinks = F.in[IN_SINK] + l * 4;
    float* ssqy = (float*)(F.ws + WS_SSQY);
    char* shm = F.ldsg + RING_OFF;
    const int G = F.G, cwg = (int)blockIdx.x, x = cwg & 7, q = cwg >> 3, gidx = q >> 3, j = q & 7;
    int tkey = -1;
    pg8::bf16x8 qn[4];
    if (G == 256) {
#pragma nounroll
    for (int i = 0; i < 4; ++i) {
        att::PolD P{proj, Y, bt, kmean, i * 8 + x, gidx, (i & 1) ? (7 - j) : j, ssqy};
        att::PolD Pn{proj, Y, bt, kmean, ((i + 1) & 3) * 8 + x, gidx, ((i + 1) & 1) ? (7 - j) : j, ssqy};
        att::PolA PA0{proj, Y, (bf16*)(F.ws + WS_YA1), (bf16*)(F.ws + WS_YA2), (float*)(F.ws + WS_LSE), bt, x, gidx, 0, j};
        att::softmax_unit(P, Pn, i + 1 < 4, PA0, i + 1 == 4, i > 0, qn, shm, tkey, F.wave);
    }
#pragma nounroll
    for (int i = 0; i < 12; ++i) {
        att::PolA P{proj, Y, (bf16*)(F.ws + WS_YA1), (bf16*)(F.ws + WS_YA2), (float*)(F.ws + WS_LSE), bt, (i / 3) * 8 + x, gidx, i % 3, j};
        const int i1 = i + 1 < 12 ? i + 1 : 0;
        att::PolA Pn{proj, Y, (bf16*)(F.ws + WS_YA1), (bf16*)(F.ws + WS_YA2), (float*)(F.ws + WS_LSE), bt, (i1 / 3) * 8 + x, gidx, i1 % 3, j};
        const int hc0 = 2 * (x & 1) + ((q >> 3) & 1);
        att::PolC PC0{proj, Y, bt, sinks[hc0] * LOG2E, (q >> 4) * 4 + (x >> 1), hc0, j, ssqy};
        att::softmax_unit(P, Pn, i + 1 < 12, PC0, i + 1 == 12, true, qn, shm, tkey, F.wave);
    }
#pragma nounroll
    for (int i = 0; i < 4; ++i) {
        const int hc = 2 * (x & 1) + ((q >> 3) & 1);
        att::PolC P{proj, Y, bt, sinks[hc] * LOG2E, i * 8 + (q >> 4) * 4 + (x >> 1), hc, j, ssqy};
        att::PolC Pn{proj, Y, bt, sinks[hc] * LOG2E, ((i + 1) & 3) * 8 + (q >> 4) * 4 + (x >> 1), hc, j, ssqy};
        att::PolSBNext PB0{proj, x, gidx, j};
        att::softmax_unit(P, Pn, i + 1 < 4, PB0, i + 1 == 4, true, qn, shm, tkey, F.wave);
    }
#pragma nounroll
    for (int i = 0; i < 4; ++i) {
        att::sb_unit(proj, Y, ssqy, i * 8 + x, gidx, j, ((i + 1) & 3) * 8 + x, j, i + 1 < 4, true, qn, shm, F.wave);
    }
    }
}
constexpr int PH_P0 = 0, PH_GKV = 1, PH_L0 = 2, PH_PER_LAYER = 10, PH_FN = PH_L0 + DEPTH * PH_PER_LAYER, NPHASE = PH_FN + 1;
#ifndef MK_SPLIT
#define MK_SPLIT 0
#endif
#define IN(k) (lo <= (k) && (k) < hi)
#define SEAM(k) do { if (IN(k) && IN((k) + 1)) xcd_barrier(bar); } while (0)
template <int l> __device__ __forceinline__ void layer_phases(Frame& F, const XcdBarrier& bar, const int lo, const int hi) {
    unsigned char* ws = F.ws;
        const int pb = PH_L0 + l * PH_PER_LAYER;
        const unsigned char* wl = ws + WS_W + (size_t)l * W_LAYER;
        float* ssqA = (float*)(ws + WS_SSQ); float* ssqB = ssqA + (size_t)M * 16; float* ssqC = ssqB + (size_t)M * 16;
        if (IN(pb + 0)) {
            pg8::Gemm g{(const bf16*)(ws + WS_XB), (const bf16*)(wl + WO_IN), M, INW, D}; pg8::StaticOrder S; S.init(M, INW, F.G, (int)blockIdx.x);
            pg8::EpiRowScale<0, true> E{(bf16*)(ws + WS_PROJ), INW, ssqA, (float*)(ws + WS_KMEAN)};
            pg8::gemm_phase<pg8::EpiRowScale<0, true>, pg8::StaticOrder, true, true>(F.lds + RING_OFF, g, S, E, F.wave);
        }
        SEAM(pb + 0);
        if (IN(pb + 2)) {
at_phase(F, l);
 }
        SEAM(pb + 2);
        if (IN(pb + 3)) { nm_merge(F); }
        SEAM(pb + 3);
        if (IN(pb + 4)) {
            pg8::Gemm g{(const bf16*)(ws + WS_Y), (const bf16*)(wl + WO_OUT), M, D, D, (const float*)(ws + WS_RAT)}; pg8::StaticOrder S; S.init(M, D, F.G, (int)blockIdx.x);
            pg8::EpiResid<true> E{(bf16*)(ws + WS_XB), ssqB};
            pg8::gemm_phase<pg8::EpiResid<true>, pg8::StaticOrder, true, true, true>(F.lds + RING_OFF, g, S, E, F.wave);
        }
        SEAM(pb + 4);
        if (IN(pb + 5)) {
            {
                pg8::StaticOrder S3; S3.init(M, XW, F.G, (int)blockIdx.x);
                pg8::Gemm g{(const bf16*)(ws + WS_XB), (const bf16*)(wl + WO_XQ), M, XW, D};
                pg8::EpiRowScale<0> E{(bf16*)(ws + WS_Q2), XW, ssqB, nullptr};
                pg8::gemm_phase<pg8::EpiRowScale<0>, pg8::StaticOrder, true, true>(F.lds + RING_OFF, g, S3, E, F.wave);
            }
            asm volatile("s_waitcnt vmcnt(0)" ::: "memory"); __syncthreads();
            if (F.G == 256) {
                pg8::StaticOrder S3; S3.init(M, XW, F.G, (int)blockIdx.x); pg8::Unit u0; S3.next(0, u0);
                char* shm = F.ldsg + RING_OFF; int tkey = -1; pg8::bf16x8 qn[4];
#pragma nounroll
                for (int hh = 0; hh < 4; ++hh) {
                    att::PolX P{(const bf16*)(ws + WS_Q2), (bf16*)(ws + WS_O2), (const bf16*)(ws + WS_KV), l, u0.pm >> 3, hh, u0.pm & 7};
                    att::PolX Pn{(const bf16*)(ws + WS_Q2), (bf16*)(ws + WS_O2), (const bf16*)(ws + WS_KV), l, u0.pm >> 3, (hh + 1) & 3, u0.pm & 7};
                    att::softmax_unit(P, Pn, hh + 1 < 4, att::PolNone{}, false, hh > 0, qn, shm, tkey, F.wave);
                }
            }
            asm volatile("s_waitcnt vmcnt(0)" ::: "memory"); __syncthreads();
            if (F.G == 256) {
                pg8::StaticOrder S3; S3.init(M, XW, F.G, (int)blockIdx.x); pg8::Unit u0; S3.next(0, u0);
                pg8::Gemm g{(const bf16*)(ws + WS_O2), (const bf16*)(wl + WO_XO), M, D, XW}; int n4 = 4; asm volatile("" : "+s"(n4));     pg8::PanelOrder S4{u0.pm, n4};
                pg8::EpiResid<false> E{(bf16*)(ws + WS_XB), ssqC};
                pg8::gemm_phase<pg8::EpiResid<false>, pg8::PanelOrder, true, true>(F.lds + RING_OFF, g, S4, E, F.wave);
            }
        }
        SEAM(pb + 5);
        if (IN(pb + 8)) {
            pg8::Gemm g{(const bf16*)(ws + WS_XB), (const bf16*)(wl + WO_UP), M, FF, D}; pg8::StaticOrder S; S.init(M, FF, F.G, (int)blockIdx.x);
            pg8::EpiRowScale<1, true> E{(bf16*)(ws + WS_H), FF, ssqC, nullptr};
            pg8::gemm_phase<pg8::EpiRowScale<1, true>, pg8::StaticOrder, true, true>(F.lds + RING_OFF, g, S, E, F.wave);
        }
        SEAM(pb + 8);
        if (IN(pb + 9)) {
            pg8::Gemm g{(const bf16*)(ws + WS_H), (const bf16*)(wl + WO_DOWN), M, D, FF}; pg8::StaticOrder S; S.init(M, D, F.G, (int)blockIdx.x);
            pg8::EpiResid<true> E{(bf16*)(ws + WS_XB), ssqA};
            pg8::gemm_phase<pg8::EpiResid<true>, pg8::StaticOrder, true, true>(F.lds + RING_OFF, g, S, E, F.wave);
        }
        SEAM(pb + 9);
}
#undef IN
#undef SEAM
struct Args { const float* in[17]; float* out; unsigned char* ws; int ph_lo, ph_hi; };
__global__ void __launch_bounds__(NWAVES * 64, 2) mk_fwd(Args args) {
    extern __shared__ __attribute__((aligned(16))) unsigned char lds[];
    Frame F;
    F.lds = (LAS unsigned char*)lds; F.ldsg = (char*)lds;
    F.MISC = (volatile LAS unsigned*)(F.lds + MISC_OFF);
    F.wave = __builtin_amdgcn_readfirstlane((int)threadIdx.x >> 6);
    F.G = gridDim.x;
    unsigned char* ws = args.ws; F.ws = ws; F.out = args.out;
    F.ctl = (gu32*)(ws + WS_CTL);
    F.in = args.in;
    for (int u = FTID; u < (LDS_BYTES - LDSCTL_OFF) / 4; u += NWAVES * 64) ((LAS unsigned*)(F.lds + LDSCTL_OFF))[u] = 0u;
    __syncthreads();
    XcdBarrier bar; bar.wave = F.wave; bar.bar = (unsigned*)(F.ctl + CW_BAR); bar.x = 0; bar.st = nullptr;
    if (!MK_SPLIT) bar = xcd_barrier_post((unsigned*)(F.ctl + CW_BAR), F.MISC + 8, F.wave);
    const int lo = args.ph_lo, hi = args.ph_hi;
#define IN(k) (lo <= (k) && (k) < hi)
#define SEAM(k) do { if (IN(k) && IN((k) + 1)) xcd_barrier(bar); } while (0)

    if (IN(PH_P0)) { p0_prologue(F); }
    SEAM(PH_P0);
    if (IN(PH_GKV)) {
        pg8::Gemm g{(const bf16*)(ws + WS_MEMN), (const bf16*)(ws + WS_WXKV), MROWS, 1024, D}; pg8::StaticOrder S; S.init(MROWS, 1024, F.G, (int)blockIdx.x);
        pg8::EpiRowScale<0> E{(bf16*)(ws + WS_KV), 1024, nullptr, nullptr};
        pg8::gemm_phase<pg8::EpiRowScale<0>, pg8::StaticOrder, true, true>(F.lds + RING_OFF, g, S, E, F.wave);
    }
    layer_phases<0>(F, bar, lo, hi);
    layer_phases<1>(F, bar, lo, hi);
    if (IN(PH_FN)) { fn_finalnorm(F, (const float*)(ws + WS_SSQ)); }
#undef IN
#undef SEAM
}

extern "C" void kernel_launch(void* const* d_in, const int* in_sizes, int n_in, void* d_out, int out_size, void* d_ws, size_t ws_size, hipStream_t stream) {
    static int grid = 0;
    if (grid == 0) {
        if (n_in != 17 || in_sizes[0] != M * D || out_size != M * D || ws_size < WS_END) { fprintf(stderr, "kernel_launch: unexpected shapes (n_in %d, in0 %d, out %d, ws %zu); nothing launched\n", n_in, n_in > 0 ? in_sizes[0] : -1, out_size, ws_size); grid = -1; return; }
        int dev = 0, cus = 0, per_cu = 0;
        if (hipGetDevice(&dev) != hipSuccess || hipDeviceGetAttribute(&cus, hipDeviceAttributeMultiprocessorCount, dev) != hipSuccess) { grid = -1; return; }
        if (hipFuncSetAttribute((const void*)mk_fwd, hipFuncAttributeMaxDynamicSharedMemorySize, LDS_BYTES) != hipSuccess) { grid = -1; return; }
        if (hipOccupancyMaxActiveBlocksPerMultiprocessor(&per_cu, (const void*)mk_fwd, NWAVES * 64, LDS_BYTES) != hipSuccess || per_cu < 1) { fprintf(stderr, "kernel_launch: occupancy query says %d\n", per_cu); }
        (void)hipGetLastError();
        grid = cus;
    }
    if (grid < 0) return;
    if (hipMemsetAsync((char*)d_ws + WS_CTL, 0, CTL_ZERO_BYTES, stream) != hipSuccess) return;
    Args a{};
    for (int i = 0; i < 17; ++i) a.in[i] = (const float*)d_in[i];
    a.out = (float*)d_out; a.ws = (unsigned char*)d_ws;
#if MK_SPLIT
    for (int p = 0; p < NPHASE; ++p) { a.ph_lo = p; a.ph_hi = p + 1; hipLaunchKernelGGL(mk_fwd, dim3(grid), dim3(NWAVES * 64), LDS_BYTES, stream, a); }
#else
    a.ph_lo = 0; a.ph_hi = NPHASE; hipLaunchKernelGGL(mk_fwd, dim3(grid), dim3(NWAVES * 64), LDS_BYTES, stream, a);
#endif
}
```

```cpp
#include <hip/hip_runtime.h>
#include <cstdio>
#include <cstdint>
namespace pg8 {
#define PG8_LAS __attribute__((address_space(3)))
typedef unsigned short bf16_t;
typedef short bf16x8 __attribute__((ext_vector_type(8)));
typedef float f32x4 __attribute__((ext_vector_type(4)));
typedef unsigned u32x4 __attribute__((ext_vector_type(4)));
constexpr int BM = 256, BK = 64, HALF = 128, HTB = HALF * BK * 2  , STAGE_BYTES = 8 * HTB, NXCD = 8, WGM = 8;

__host__ __device__ __forceinline__ int lds_byte(int r, int c) { return r * 128 + ((((c >> 3) ^ ((r >> 1) & 7))) << 4) + (c & 7) * 2; }
__host__ __device__ __forceinline__ void stage_rc(int b, int& R, int& C) { R = b >> 7; C = ((((b & 127) >> 4) ^ ((R >> 1) & 7))) * 8; }
__host__ __device__ __forceinline__ int perm32(int rho) { const int n = rho >> 4, i = rho & 15; return 8 * (i >> 2) + 4 * n + (i & 3); }

struct Unit { int pm, pn; };
struct Gemm { const bf16_t* A; const bf16_t* Bt; int M, N, K; const float* hr = nullptr; };

struct StaticOrder {
    int nM, nN, nwg, G, c;
    __host__ __device__ void init(int M, int N, int G_, int c_) { nM = M / BM; nN = N / BM; nwg = nM * nN; G = G_; c = c_; }
    __host__ __device__ bool next(int i, Unit& u) const {
        const long L = (long)i * G + c; if (L >= nwg) return false;
        int wgid = (int)L; { const int q = nwg / NXCD, r = nwg % NXCD, xcd = wgid % NXCD, off = wgid / NXCD; wgid = (xcd < r ? xcd * (q + 1) : r * (q + 1) + (xcd - r) * q) + off; }
        const int nig = WGM * nN, gid = wgid / nig, fm = gid * WGM, gsz = (nM - fm) < WGM ? (nM - fm) : WGM;
        u.pm = fm + ((wgid % nig) % gsz); u.pn = (wgid % nig) / gsz; return true;
    }
    __device__ __forceinline__ void a_ready(const Unit&) const {}
    __device__ __forceinline__ void done(const Unit&) const {}
};

struct PanelOrder {
    int pm, nN;
    __device__ __forceinline__ bool next(int i, Unit& u) const { if (i >= nN) return false; u.pm = pm; u.pn = i; return true; }
    __device__ __forceinline__ void a_ready(const Unit&) const {}
    __device__ __forceinline__ void done(const Unit&) const {}
};

__device__ __forceinline__ unsigned cvt_pk_bf16(float lo, float hi) { unsigned r; asm volatile("v_cvt_pk_bf16_f32 %0, %1, %2" : "=v"(r) : "v"(lo), "v"(hi)); return r; }
typedef float f32x2 __attribute__((ext_vector_type(2)));
constexpr float RMS_EPS = 1e-6f;
__device__ __forceinline__ float row_rs(const float* ssq, int row) {
    const f32x4* p = (const f32x4*)(ssq + (size_t)row * 16);
    const f32x4 a = p[0], b = p[1], c = p[2], d = p[3];
    const float s = (((a[0] + a[1]) + (a[2] + a[3])) + ((b[0] + b[1]) + (b[2] + b[3]))) + (((c[0] + c[1]) + (c[2] + c[3])) + ((d[0] + d[1]) + (d[2] + d[3])));
    return __builtin_amdgcn_rsqf(s * (1.0f / 1024.0f) + RMS_EPS);
}
template <int ACT, bool NT = false> struct EpiRowScale {
    static constexpr bool PERM = true, AFTER_DRAIN = false; static constexpr int MIN_VMEM = 16;
    bf16_t* O; int ldc; const float* ssq; float* kmp;
    __device__ __forceinline__ void operator()(const f32x4 (&acc)[2][2][4][2], const Unit& u, int wr, int wc, int fr, int fq) const {
        const int row0 = u.pm * BM + wr * 64 + fr, col0 = u.pn * BM + wc * 64 + 8 * fq;
        float rs[2][4];
        if (ssq) {
            f32x4 q4[2][4];
#pragma unroll
            for (int ai = 0; ai < 2; ++ai)
#pragma unroll
                for (int m = 0; m < 4; ++m) q4[ai][m] = *(const f32x4*)(ssq + (size_t)(row0 + ai * HALF + m * 16) * 16 + 4 * fq);
#pragma unroll
            for (int ai = 0; ai < 2; ++ai)
#pragma unroll
                for (int m = 0; m < 4; ++m) { float s = (q4[ai][m][0] + q4[ai][m][1]) + (q4[ai][m][2] + q4[ai][m][3]); s += __shfl_xor(s, 16); s += __shfl_xor(s, 32);
                    rs[ai][m] = __builtin_amdgcn_rsqf(s * (1.0f / 1024.0f) + RMS_EPS); }
        } else {
#pragma unroll
            for (int ai = 0; ai < 2; ++ai)
#pragma unroll
                for (int m = 0; m < 4; ++m) rs[ai][m] = 1.0f;
        }
        if (ACT == 0 && kmp != nullptr && u.pn == 9) {
#pragma unroll
            for (int bj = 0; bj < 2; ++bj)
#pragma unroll
                for (int n = 0; n < 2; ++n) {
                    f32x4 cs = {0.f, 0.f, 0.f, 0.f};
#pragma unroll
                    for (int ai = 0; ai < 2; ++ai)
#pragma unroll
                        for (int m = 0; m < 4; ++m) { float rk = rs[ai][m]; asm volatile("" : "+v"(rk)); cs += acc[ai][bj][m][n] * rk; }
#pragma unroll
                    for (int e = 0; e < 4; ++e) { float v = cs[e]; v += __shfl_xor(v, 1); v += __shfl_xor(v, 2); v += __shfl_xor(v, 4); v += __shfl_xor(v, 8); cs[e] = v; }
                    if (fr == 0) *(f32x4*)(kmp + ((size_t)u.pm * 2 + wr) * 256 + wc * 64 + bj * 32 + 8 * fq + 4 * n) = cs;
                }
        }
        const int odd = fr & 1;
        bf16_t* pbase = O + (size_t)(row0 - odd) * ldc + col0 + odd * 32;
#pragma unroll
        for (int ai = 0; ai < 2; ++ai)
#pragma unroll
            for (int m = 0; m < 4; ++m) {
                u32x4 w[2];
#pragma unroll
                for (int bj = 0; bj < 2; ++bj) {
                    f32x4 v0 = acc[ai][bj][m][0] * rs[ai][m], v1 = acc[ai][bj][m][1] * rs[ai][m];
                    if (ACT == 1) {
#pragma unroll
                        for (int e = 0; e < 4; ++e) { const float a = __builtin_fmaxf(v0[e], 0.f), b = __builtin_fmaxf(v1[e], 0.f); v0[e] = a * a; v1[e] = b * b; }
                    }
                    w[bj].x = cvt_pk_bf16(v0[0], v0[1]); w[bj].y = cvt_pk_bf16(v0[2], v0[3]); w[bj].z = cvt_pk_bf16(v1[0], v1[1]); w[bj].w = cvt_pk_bf16(v1[2], v1[3]);
                }
                const u32x4 snd = odd ? w[0] : w[1]; u32x4 rcv;
#pragma unroll
                for (int e = 0; e < 4; ++e) rcv[e] = (unsigned)__builtin_amdgcn_update_dpp(0, (int)snd[e], 0xB1, 0xF, 0xF, true);
                bf16_t* p = pbase + (size_t)(ai * HALF + m * 16) * ldc;
                if (NT) { __builtin_nontemporal_store(odd ? rcv : w[0], (u32x4*)p); __builtin_nontemporal_store(odd ? w[1] : rcv, (u32x4*)(p + ldc)); }
                else { *(u32x4*)p = odd ? rcv : w[0]; *(u32x4*)(p + ldc) = odd ? w[1] : rcv; }
            }
    }
};
template <bool DEEP> struct EpiResid {
    static constexpr bool PERM = true, AFTER_DRAIN = false; static constexpr int MIN_VMEM = 16;
    bf16_t* xb; float* ssq;
    __device__ __forceinline__ void operator()(const f32x4 (&acc)[2][2][4][2], const Unit& u, int wr, int wc, int fr, int fq) const {
        const int row0 = u.pm * BM + wr * 64 + fr, col0 = u.pn * BM + wc * 64 + 8 * fq, slot = u.pn * 4 + wc;
        char* const xbase = (char*)xb; char* const sbase = (char*)ssq;
        const int odd = fr & 1;
        const unsigned xoff0 = ((unsigned)(row0 - odd) * 1024u + (unsigned)(col0 + odd * 32)) * 2u, soff0 = ((unsigned)row0 * 16u + (unsigned)slot) * 4u;
#define ERL(dst, am_) do { _Pragma("unroll") for (int mm = 0; mm < 2; ++mm) _Pragma("unroll") for (int rr = 0; rr < 2; ++rr) \
            dst[mm][rr] = *(const u32x4*)(xbase + (xoff0 + (unsigned)((((am_) >> 1) * HALF + (((am_) & 1) * 2 + mm) * 16 + rr) * 2048))); } while (0)
#define EDPP(x) ((unsigned)__builtin_amdgcn_update_dpp(0, (int)(x), 0xB1, 0xF, 0xF, true))
        u32x4 xin[2][2], xnx[2][2];
        ERL(xin, 0);
#pragma unroll
        for (int am = 0; am < 4; ++am) {
            const int ai = am >> 1;
            if (DEEP) { if (am < 3) ERL(xnx, am + 1); }
#pragma unroll
            for (int mm = 0; mm < 2; ++mm) {
                const int m = (am & 1) * 2 + mm;
                const u32x4 la = xin[mm][0], lb = xin[mm][1];
                const u32x4 snd = odd ? la : lb; u32x4 rcv;
#pragma unroll
                for (int e = 0; e < 4; ++e) rcv[e] = EDPP(snd[e]);
                const u32x4 b0 = odd ? rcv : la, b1 = odd ? lb : rcv;
                u32x4 w[2]; float ss = 0.f;
#pragma unroll
                for (int bj = 0; bj < 2; ++bj) {
                    const u32x4 b = bj ? b1 : b0;
                    const f32x4 a0 = acc[ai][bj][m][0], a1 = acc[ai][bj][m][1];
                    w[bj].x = cvt_pk_bf16(a0[0] + __builtin_bit_cast(float, b.x << 16), a0[1] + __builtin_bit_cast(float, b.x & 0xffff0000u));
                    w[bj].y = cvt_pk_bf16(a0[2] + __builtin_bit_cast(float, b.y << 16), a0[3] + __builtin_bit_cast(float, b.y & 0xffff0000u));
                    w[bj].z = cvt_pk_bf16(a1[0] + __builtin_bit_cast(float, b.z << 16), a1[1] + __builtin_bit_cast(float, b.z & 0xffff0000u));
                    w[bj].w = cvt_pk_bf16(a1[2] + __builtin_bit_cast(float, b.w << 16), a1[3] + __builtin_bit_cast(float, b.w & 0xffff0000u));
#pragma unroll
                    for (int e = 0; e < 4; ++e) { const float lo = __builtin_bit_cast(float, w[bj][e] << 16), hi = __builtin_bit_cast(float, w[bj][e] & 0xffff0000u); ss += lo * lo + hi * hi; }
                }
                const u32x4 snd2 = odd ? w[0] : w[1]; u32x4 rcv2;
#pragma unroll
                for (int e = 0; e < 4; ++e) rcv2[e] = EDPP(snd2[e]);
                char* p = xbase + (xoff0 + (unsigned)((ai * HALF + m * 16) * 2048));
                __builtin_nontemporal_store(odd ? rcv2 : w[0], (u32x4*)p); __builtin_nontemporal_store(odd ? w[1] : rcv2, (u32x4*)(p + 2048));
                ss += __shfl_xor(ss, 16); ss += __shfl_xor(ss, 32);
                if (fq == 0) *(float*)(sbase + (soff0 + (unsigned)((ai * HALF + m * 16) * 64))) = ss;
            }
            asm volatile("" ::: "memory");
            if (DEEP) {
#pragma unroll
                for (int mm = 0; mm < 2; ++mm)
#pragma unroll
                    for (int rr = 0; rr < 2; ++rr) xin[mm][rr] = xnx[mm][rr];
            } else { if (am < 3) ERL(xin, am + 1); }
        }
#undef EDPP
#undef ERL
    }
};

__device__ __forceinline__ int pg8_lane_id() { int l; asm volatile("v_mbcnt_lo_u32_b32 %0, -1, 0\n\tv_mbcnt_hi_u32_b32 %0, -1, %0" : "=v"(l)); return l; }
template <class Epi, class Sched, bool ALIGN_EPI = false, bool SP2 = false, bool HORNER = false>
__device__ __forceinline__ void gemm_phase(PG8_LAS unsigned char* lds, const Gemm g, const Sched& S, const Epi& E, const int wave_) {
    const int wid = wave_, lane = pg8_lane_id(), tid = wid * 64 + lane, wr = wid >> 2, wc = wid & 3, fr = lane & 15, fq = lane >> 4;
    const int K = g.K, nt = K / BK;
    unsigned voffA, voffB;
    { int R, C; stage_rc(tid * 16, R, C); const int Rb = 64 * (R >> 5) + perm32(R & 31);
      voffA = (unsigned)(R * K + C) * 2u; voffB = (unsigned)(Rb * K + C) * 2u; }
    const size_t pstepA = (size_t)64 * K * 2, pstepB = (size_t)128 * K * 2, hstepB = (size_t)32 * K * 2;
    const size_t kstep = (size_t)(BK * 2);
    const size_t hstep = (size_t)HALF * K * 2;
    const size_t tstep = 2 * hstep;
    const unsigned ldsw = (unsigned)wid * 1024u;
    const int aoff0 = lds_byte(wr * 64 + fr, fq * 8), boff0 = lds_byte(wc * 32 + fr, fq * 8);
#define PG8_SA(b, h) (((b) * 2 + (h)) * HTB)
#define PG8_SB(b, h) ((4 + (b) * 2 + (h)) * HTB)
#define PG8_STAGE4(bufoff, gbase, voff, pst) do { _Pragma("unroll") for (int _i = 0; _i < 2; ++_i) \
        __builtin_amdgcn_global_load_lds((const unsigned*)((const char*)(gbase) + _i * (pst) + (voff)), (PG8_LAS unsigned*)(lds + (bufoff) + ldsw + _i * 8192), 16, 0, 0); } while (0)
#define PG8_LDA(dst, b, h) do { int a1_ = aoff0 ^ 64; asm volatile("" : "+v"(a1_)); _Pragma("unroll") for (int m = 0; m < 4; ++m) _Pragma("unroll") for (int k = 0; k < 2; ++k) dst[m][k] = *(const PG8_LAS bf16x8*)(lds + PG8_SA(b, h) + (k == 0 ? aoff0 : a1_) + m * 2048); } while (0)
#define PG8_LDB(dst, b, h) do { int b1_ = boff0 ^ 64; asm volatile("" : "+v"(b1_)); _Pragma("unroll") for (int n = 0; n < 2; ++n) _Pragma("unroll") for (int k = 0; k < 2; ++k) dst[n][k] = *(const PG8_LAS bf16x8*)(lds + PG8_SB(b, h) + (k == 0 ? boff0 : b1_) + n * 2048); } while (0)
#define PG8_MMA(ai, bj, At, Bt) do { __builtin_amdgcn_s_setprio(1); _Pragma("unroll") for (int m = 0; m < 4; ++m) _Pragma("unroll") for (int n = 0; n < 2; ++n) _Pragma("unroll") for (int k = 0; k < 2; ++k) \
        acc[ai][bj][m][n] = __builtin_amdgcn_mfma_f32_16x16x32_bf16(Bt[n][k], At[m][k], acc[ai][bj][m][n], 0, 0, 0); __builtin_amdgcn_s_setprio(0); } while (0)
#define PG8_WAIT_V(n) asm volatile("s_waitcnt vmcnt(" #n ")" ::: "memory")
#define PG8_WAIT_L(n) asm volatile("s_waitcnt lgkmcnt(" #n ")" ::: "memory")
#define PG8_BAR __builtin_amdgcn_s_barrier()
#define PG8_SCHED __builtin_amdgcn_sched_barrier(0)
    Unit cur, nxt; int ui = 0;
    if (!S.next(0, cur)) return;
#define PG8_HSCALE(buf, k) do { const int l_ = pg8_lane_id(); PG8_LAS const float* hp_ = (PG8_LAS const float*)(lds + STAGE_BYTES) + (buf) * 1024 + ((wid >> 2) * 64 + (l_ & 15)) * 4 + (k); \
        _Pragma("unroll") for (int a_ = 0; a_ < 2; ++a_) _Pragma("unroll") for (int m_ = 0; m_ < 4; m_ += 2) { \
            float f0_ = hp_[(128 * a_ + 16 * m_) * 4], f1_ = hp_[(128 * a_ + 16 * m_ + 16) * 4]; asm volatile("s_waitcnt lgkmcnt(0)" : "+v"(f0_), "+v"(f1_)); \
            _Pragma("unroll") for (int b_ = 0; b_ < 2; ++b_) _Pragma("unroll") for (int n_ = 0; n_ < 2; ++n_) { acc[a_][b_][m_][n_] *= f0_; acc[a_][b_][m_ + 1][n_] *= f1_; } \
            __builtin_amdgcn_sched_barrier(0); } } while (0)
#define PG8_HFETCH(dst, pm_) do { const int t_ = wid * 64 + pg8_lane_id(); if (t_ < 256) dst = *(const f32x4*)(g.hr + ((size_t)(pm_) * BM + t_) * 4); } while (0)
#define PG8_HPARK(src, buf) do { const int t_ = wid * 64 + pg8_lane_id(); if (t_ < 256) *(PG8_LAS f32x4*)((PG8_LAS float*)(lds + STAGE_BYTES) + (buf) * 1024 + t_ * 4) = src; } while (0)
    if constexpr (HORNER) { f32x4 h0 = {1.f, 1.f, 1.f, 1.f}; PG8_HFETCH(h0, cur.pm); PG8_HPARK(h0, 0); }
    f32x4 acc[2][2][4][2];
#pragma unroll
    for (int a = 0; a < 2; ++a)
#pragma unroll
        for (int b = 0; b < 2; ++b)
#pragma unroll
            for (int m = 0; m < 4; ++m)
#pragma unroll
                for (int n = 0; n < 2; ++n) acc[a][b][m][n] = (f32x4){0.f, 0.f, 0.f, 0.f};
    bf16x8 At[4][2], B0[2][2], B1[2][2];
    const char* cA = (const char*)g.A + (size_t)cur.pm * tstep; const char* cB = (const char*)g.Bt + (size_t)cur.pn * tstep;
    S.a_ready(cur);
    if constexpr (SP2) {
        PG8_STAGE4(PG8_SB(0, 0), cB, voffB, pstepB); PG8_STAGE4(PG8_SB(0, 1), cB + hstepB, voffB, pstepB); PG8_STAGE4(PG8_SA(0, 0), cA, voffA, pstepA); PG8_STAGE4(PG8_SA(0, 1), cA + hstep, voffA, pstepA);
        if (wr == 1) PG8_BAR;
        PG8_WAIT_V(2); PG8_BAR;
        PG8_STAGE4(PG8_SB(1, 0), cB + kstep, voffB, pstepB); PG8_STAGE4(PG8_SA(1, 0), cA + kstep, voffA, pstepA); PG8_STAGE4(PG8_SB(1, 1), cB + hstepB + kstep, voffB, pstepB);
        PG8_WAIT_V(6); PG8_BAR;
    } else {
        PG8_STAGE4(PG8_SB(0, 0), cB, voffB, pstepB); PG8_STAGE4(PG8_SA(0, 0), cA, voffA, pstepA); PG8_STAGE4(PG8_SB(0, 1), cB + hstepB, voffB, pstepB); PG8_STAGE4(PG8_SA(0, 1), cA + hstep, voffA, pstepA);
        if (wr == 1) PG8_BAR;
        PG8_WAIT_V(4); PG8_BAR;
        PG8_STAGE4(PG8_SB(1, 0), cB + kstep, voffB, pstepB); PG8_STAGE4(PG8_SA(1, 0), cA + kstep, voffA, pstepA); PG8_STAGE4(PG8_SB(1, 1), cB + hstepB + kstep, voffB, pstepB);
        PG8_WAIT_V(6); PG8_BAR;
    }
    for (;;) {
        const bool has_next = S.next(ui + 1, nxt);
        const char* nA = has_next ? (const char*)g.A + (size_t)nxt.pm * tstep : cA; const char* nB = has_next ? (const char*)g.Bt + (size_t)nxt.pn * tstep : cB;
        for (int tb = 0; tb < nt; tb += (HORNER ? 4 : nt)) {
        const int te = HORNER ? tb + 4 : nt;
        for (int t = tb; t < te; t += 2) {
            const bool last = (t == nt - 2);
            const char* a1 = cA + (size_t)(t + 1) * kstep;
            const char* a2 = last ? nA : cA + (size_t)(t + 2) * kstep; const char* b2 = last ? nB : cB + (size_t)(t + 2) * kstep;
            const char* a3 = a2 + kstep; const char* b3 = b2 + kstep;
            if (last && has_next) S.a_ready(nxt);
            if constexpr (SP2) {
            PG8_LDB(B0, 0, 0); PG8_LDB(B1, 0, 1); PG8_SCHED; PG8_LDA(At, 0, 0); PG8_STAGE4(PG8_SA(1, 1), a1 + hstep, voffA, pstepA);
            PG8_WAIT_V(8); PG8_WAIT_L(0); PG8_BAR; PG8_MMA(0, 0, At, B0); PG8_MMA(0, 1, At, B1); PG8_BAR; PG8_SCHED;
            PG8_LDA(At, 0, 1); PG8_STAGE4(PG8_SB(0, 0), b2, voffB, pstepB); PG8_STAGE4(PG8_SB(0, 1), b2 + hstepB, voffB, pstepB); PG8_STAGE4(PG8_SA(0, 0), a2, voffA, pstepA);
            PG8_WAIT_V(8); PG8_WAIT_L(0); PG8_BAR; PG8_MMA(1, 0, At, B0); PG8_MMA(1, 1, At, B1); PG8_BAR; PG8_SCHED;
            PG8_LDB(B0, 1, 0); PG8_LDB(B1, 1, 1); PG8_SCHED; PG8_LDA(At, 1, 0); PG8_STAGE4(PG8_SA(0, 1), a2 + hstep, voffA, pstepA);
            PG8_WAIT_V(8); PG8_WAIT_L(0); PG8_BAR; PG8_MMA(0, 0, At, B0); PG8_MMA(0, 1, At, B1); PG8_BAR; PG8_SCHED;
            PG8_LDA(At, 1, 1); PG8_STAGE4(PG8_SB(1, 0), b3, voffB, pstepB); PG8_STAGE4(PG8_SB(1, 1), b3 + hstepB, voffB, pstepB); PG8_STAGE4(PG8_SA(1, 0), a3, voffA, pstepA);
            PG8_WAIT_V(8); PG8_WAIT_L(0); PG8_BAR; PG8_MMA(1, 0, At, B0); PG8_MMA(1, 1, At, B1); PG8_BAR; PG8_SCHED;
            } else {
            PG8_LDB(B0, 0, 0); PG8_SCHED; PG8_LDA(At, 0, 0); PG8_STAGE4(PG8_SA(1, 1), a1 + hstep, voffA, pstepA);
            PG8_WAIT_L(8); PG8_BAR; PG8_WAIT_L(0); PG8_MMA(0, 0, At, B0); PG8_BAR; PG8_SCHED;
            PG8_LDB(B1, 0, 1); PG8_STAGE4(PG8_SB(0, 0), b2, voffB, pstepB);
            PG8_BAR; PG8_WAIT_L(0); PG8_MMA(0, 1, At, B1); PG8_BAR;
            PG8_LDA(At, 0, 1); PG8_STAGE4(PG8_SA(0, 0), a2, voffA, pstepA);
            PG8_BAR; PG8_WAIT_L(0); PG8_MMA(1, 0, At, B0); PG8_BAR; PG8_SCHED;
            PG8_STAGE4(PG8_SB(0, 1), b2 + hstepB, voffB, pstepB);
            PG8_WAIT_V(6); PG8_BAR; PG8_MMA(1, 1, At, B1); PG8_BAR;
            PG8_LDB(B0, 1, 0); PG8_SCHED; PG8_LDA(At, 1, 0); PG8_STAGE4(PG8_SA(0, 1), a2 + hstep, voffA, pstepA);
            PG8_WAIT_L(8); PG8_BAR; PG8_WAIT_L(0); PG8_MMA(0, 0, At, B0); PG8_BAR; PG8_SCHED;
            PG8_LDB(B1, 1, 1); PG8_STAGE4(PG8_SB(1, 0), b3, voffB, pstepB);
            PG8_BAR; PG8_WAIT_L(0); PG8_MMA(0, 1, At, B1); PG8_BAR;
            PG8_LDA(At, 1, 1); PG8_STAGE4(PG8_SA(1, 0), a3, voffA, pstepA);
            PG8_BAR; PG8_WAIT_L(0); PG8_MMA(1, 0, At, B0); PG8_BAR; PG8_SCHED;
            PG8_STAGE4(PG8_SB(1, 1), b3 + hstepB, voffB, pstepB);
            PG8_WAIT_V(6); PG8_BAR; PG8_MMA(1, 1, At, B1); PG8_BAR;
            }
        }
        if constexpr (HORNER) PG8_HSCALE(ui & 1, tb >> 2);
        }
        if constexpr (HORNER) {
            f32x4 hn = {1.f, 1.f, 1.f, 1.f};
            if (has_next) { PG8_HFETCH(hn, nxt.pm); PG8_HPARK(hn, (ui + 1) & 1); }
        }
        if constexpr (ALIGN_EPI) { if (wr == 0) PG8_BAR; }
        if constexpr (!Epi::AFTER_DRAIN) { E(acc, cur, wr, wc, fr, fq); S.done(cur); }
        if (!has_next) break;
#pragma unroll
        for (int a = 0; a < 2; ++a)
#pragma unroll
            for (int b = 0; b < 2; ++b)
#pragma unroll
                for (int m = 0; m < 4; ++m)
#pragma unroll
                    for (int n = 0; n < 2; ++n) acc[a][b][m][n] = (f32x4){0.f, 0.f, 0.f, 0.f};
        cur = nxt; cA = nA; cB = nB; ++ui;
        if constexpr (ALIGN_EPI) { if (wr == 1) PG8_BAR; }
    }
    PG8_WAIT_V(0);
    if constexpr (!ALIGN_EPI) { if (wr == 0) PG8_BAR; }
    PG8_BAR;
    if constexpr (Epi::AFTER_DRAIN) { E.fused(acc, cur, wr, wc, fr, fq, lds, wid, lane); S.done(cur); }
#undef PG8_SA
#undef PG8_SB
#undef PG8_STAGE4
#undef PG8_LDA
#undef PG8_LDB
#undef PG8_MMA
#undef PG8_WAIT_V
#undef PG8_WAIT_L
#undef PG8_BAR
#undef PG8_SCHED
}
}
#define GAS __attribute__((address_space(1)))
#define LAS __attribute__((address_space(3)))
typedef unsigned short bf16;
typedef unsigned v4u __attribute__((ext_vector_type(4)));
typedef float f32x4 __attribute__((ext_vector_type(4)));
typedef short bf16x8 __attribute__((ext_vector_type(8)));
typedef GAS unsigned gu32;
typedef GAS unsigned long long gu64;
#define RLX_AGENT __ATOMIC_RELAXED, __HIP_MEMORY_SCOPE_AGENT
#define LDS_WAIT() asm volatile("s_waitcnt lgkmcnt(0)" ::: "memory")
#define VM_WAIT() asm volatile("s_waitcnt vmcnt(0)" ::: "memory")
__device__ __forceinline__ unsigned long long rt() { return __builtin_amdgcn_s_memrealtime(); }
__device__ __forceinline__ unsigned f2bf(float f) { unsigned u = __builtin_bit_cast(unsigned, f); return (u + 0x7fffu + ((u >> 16) & 1u)) >> 16; }
__device__ __forceinline__ unsigned pk2(float lo, float hi) { return f2bf(lo) | (f2bf(hi) << 16); }
__device__ __forceinline__ int lane_id() { int l; asm volatile("v_mbcnt_lo_u32_b32 %0, -1, 0\n\tv_mbcnt_hi_u32_b32 %0, -1, %0" : "=v"(l)); return l; }
#define XB_TMO      128
#define XB_XCNT(j)  (256  + 64 * (j))
#define XB_XSUB(j)  (1280 + 64 * (j))
#define XB_XGEN(j)  (2304 + 64 * (j))
#define XB_TOP      3328
#define XB_TOPGEN   3392
#define XCD_BAR_WORDS 3456
#define XB_SPIN_CAP (1u << 18)

__device__ __forceinline__ unsigned xb_ld(unsigned* p)              { return __hip_atomic_load(p, __ATOMIC_RELAXED, __HIP_MEMORY_SCOPE_AGENT); }
__device__ __forceinline__ unsigned xb_add(unsigned* p, unsigned v) { return __hip_atomic_fetch_add(p, v, __ATOMIC_RELAXED, __HIP_MEMORY_SCOPE_AGENT); }
__device__ __forceinline__ unsigned xb_xcc_id() { return (unsigned)__builtin_amdgcn_s_getreg((3 << 11) | 20) & 0xFu; }
#define XB_SPIN(cond, bar) do { unsigned _sp = 0; while (cond) { __builtin_amdgcn_s_sleep(1); \
    if ((++_sp & 255u) == 0u) { if (xb_ld(&(bar)[XB_TMO])) break; if (_sp > XB_SPIN_CAP) { atomicAdd(&(bar)[XB_TMO], 1u); break; } } } } while (0)

struct XcdBarrier {
    int wave;
    unsigned* bar; unsigned x;
    volatile LAS unsigned* st;
};

__device__ __forceinline__ XcdBarrier xcd_barrier_post(unsigned* bar, volatile LAS unsigned* st, int wave) {
    XcdBarrier b; b.wave = wave; b.bar = bar; b.x = xb_xcc_id(); b.st = st;
    if (wave == 0 && lane_id() == 0) (void)xb_add(&bar[XB_XCNT(b.x)], 1u);
    return b;
}
__device__ __forceinline__ void xcd_barrier_complete(unsigned* bar, unsigned x, unsigned& nloc, unsigned& nx) {
    const unsigned G = gridDim.x * gridDim.y * gridDim.z;
    unsigned sum, cnt, mine, sp = 0u;
    for (;;) {
        sum = 0u; cnt = 0u; mine = 0u;
#pragma unroll
        for (unsigned j = 0; j < 16; ++j) { const unsigned c = xb_ld(&bar[XB_XCNT(j)]); sum += c; cnt += (c > 0u) ? 1u : 0u; mine = (j == x) ? c : mine; }
        if (sum == G) break;
        __builtin_amdgcn_s_sleep(1);
        if ((++sp & 255u) == 0u) { if (xb_ld(&bar[XB_TMO])) break; if (sp > XB_SPIN_CAP) { atomicAdd(&bar[XB_TMO], 1u); break; } }
    }
    nloc = mine > 0u ? mine : 1u; nx = cnt > 0u ? cnt : 1u;
}

__device__ __forceinline__ void xcd_barrier(const XcdBarrier& b) {
    asm volatile("s_waitcnt vmcnt(0)" ::: "memory");
    __syncthreads();
    if (b.wave == 0 && lane_id() == 0) {
        unsigned* bar = b.bar;
        __builtin_amdgcn_s_waitcnt(0);
        unsigned nloc = b.st[0], nx = b.st[1];
        if (nloc == 0u) { xcd_barrier_complete(bar, b.x, nloc, nx); b.st[0] = nloc; b.st[1] = nx; }
        const unsigned old = xb_add(&bar[XB_XSUB(b.x)], 1u);
        const unsigned gen = old / nloc;
        if (old + 1u == (gen + 1u) * nloc) {
            __builtin_amdgcn_fence(__ATOMIC_RELEASE, "agent");
            asm volatile("s_waitcnt vmcnt(0)" ::: "memory");
            const unsigned og = xb_add(&bar[XB_TOP], 1u);
            const unsigned tg = og / nx;
            if (og + 1u == (tg + 1u) * nx) xb_add(&bar[XB_TOPGEN], 1u);
            else XB_SPIN(xb_ld(&bar[XB_TOPGEN]) == tg, bar);
            __builtin_amdgcn_fence(__ATOMIC_ACQUIRE, "agent");
            xb_add(&bar[XB_XGEN(b.x)], 1u);
            asm volatile("s_waitcnt vmcnt(0)" ::: "memory");
        } else {
            XB_SPIN(xb_ld(&bar[XB_XGEN(b.x)]) == gen, bar);
            __builtin_amdgcn_fence(__ATOMIC_ACQUIRE, "agent");
            asm volatile("s_waitcnt vmcnt(0)" ::: "memory");
        }
    }
    __syncthreads();
}
constexpr int NWAVES = 8;
constexpr int BATCH = 32, SEQ = 2048, D = 1024, M = BATCH * SEQ, INW = 2816, FF = 4096, MEMLEN = 256, MROWS = BATCH * MEMLEN, XW = 256, DEPTH = 2;
constexpr float NORM_EPS = 1e-6f;
constexpr float LOG2E = 1.4426950408889634f;
constexpr float C2 = 0.125f * LOG2E;
constexpr int COL_AQ = 0, COL_AK = 256, COL_AV = 512, COL_BQ = 768, COL_BK = 1024, COL_BV = 1280, COL_CQ = 1536, COL_CK = 1792, COL_CV = 1920, COL_DQ = 2048, COL_DK = 2304, COL_DV = 2560;
constexpr int BT_STRIDE = 2112;

constexpr size_t MiB = 1u << 20;
constexpr size_t WS_CTL = 0, CTL_ZERO_BYTES = 32768;
constexpr size_t WS_BT = 1 * MiB;
constexpr size_t WS_KMEAN = 1 * MiB + 512 * 1024;
constexpr size_t WS_W = 2 * MiB, W_LAYER = 26 * MiB;
constexpr size_t WO_IN = 0, WO_OUT = WO_IN + (size_t)INW * D * 2, WO_XQ = WO_OUT + (size_t)D * D * 2, WO_XO = WO_XQ + (size_t)XW * D * 2, WO_UP = WO_XO + (size_t)D * XW * 2, WO_DOWN = WO_UP + (size_t)FF * D * 2;
static_assert(WO_DOWN + (size_t)D * FF * 2 <= W_LAYER, "weights per layer");
constexpr size_t WS_WXKV = WS_W + 2 * W_LAYER;
constexpr size_t WS_SSQ = 56 * MiB;
constexpr size_t WS_MEMN = 68 * MiB;
constexpr size_t WS_KV = 84 * MiB;
constexpr size_t WS_Q2 = 100 * MiB;
constexpr size_t WS_LSE = 132 * MiB;
constexpr size_t WS_XB = 136 * MiB;
constexpr size_t WS_PROJ = 264 * MiB;
constexpr size_t WS_Y = 616 * MiB;
constexpr size_t WS_YA1 = 744 * MiB, WS_YA2 = 776 * MiB;
constexpr size_t WS_H = 264 * MiB;
constexpr size_t WS_O2 = 808 * MiB;
constexpr size_t WS_SSQY = 840 * MiB;
constexpr size_t WS_RAT = 844 * MiB;
constexpr size_t WS_END = 848 * MiB;
static_assert(WS_PROJ + (size_t)M * INW * 2 <= WS_Y && WS_H + (size_t)M * FF * 2 <= WS_END && WS_XB + (size_t)M * D * 2 <= WS_PROJ, "d_ws map");
constexpr int CW_TMO = 0, CW_CODE = 1, CW_BAR = 4096;

constexpr int RING_OFF = 0, RING_BYTES = 131072;
constexpr int LDSCTL_OFF = 143360, MISC_OFF = LDSCTL_OFF + 320;
constexpr int LDS_BYTES = 147456;
__device__ __forceinline__ float wave_sum(float v) {
#pragma unroll
    for (int o = 1; o < 64; o <<= 1) v += __shfl_xor(v, o);
    return v;
}
__device__ __forceinline__ float bf_lo(unsigned u) { return __builtin_bit_cast(float, u << 16); }
__device__ __forceinline__ float bf_hi(unsigned u) { return __builtin_bit_cast(float, u & 0xffff0000u); }
__device__ __forceinline__ float ex2(float x) { return __builtin_amdgcn_exp2f(x); }
__device__ __forceinline__ float lg2(float x) { return __builtin_amdgcn_logf(x); }

__device__ __forceinline__ int rel_bucket(int n) {
    if (n < 16) return n;
    int b = 16;
    b += (n >= 22); b += (n >= 30); b += (n >= 40); b += (n >= 54); b += (n >= 73); b += (n >= 99); b += (n >= 134); b += (n >= 182);
    b += (n >= 246); b += (n >= 332); b += (n >= 450); b += (n >= 609); b += (n >= 825); b += (n >= 1117); b += (n >= 1513);
    return b;
}

__device__ __forceinline__ void p0_transpose_item(const float* W, int K, int N, bf16* WT, const float* g, unsigned qmask, LAS float* scr, int item, int lane) {
    const int nblk = N / 32, kb = item / nblk, nb = item % nblk, k0 = 64 * kb, n0 = 32 * nb;
    const float cs = ((qmask >> (n0 >> 8)) & 1u) ? C2 : 1.0f;
    float wv[32], gv[32];
#pragma unroll
    for (int i = 0; i < 32; ++i) { const int kk = 2 * i + (lane >> 5); wv[i] = W[(size_t)(k0 + kk) * N + n0 + (lane & 31)]; gv[i] = g ? g[k0 + kk] : 1.0f; }
#pragma unroll
    for (int i = 0; i < 32; ++i) { const int kk = 2 * i + (lane >> 5); scr[kk * 33 + (lane & 31)] = wv[i] * (gv[i] * cs); }
    LDS_WAIT(); asm volatile("" ::: "memory");
    const int c = lane & 7;
#pragma unroll
    for (int j = 0; j < 4; ++j) { const int n = (lane >> 3) + 8 * j; const LAS float* s = scr + (8 * c) * 33 + n;
        v4u o; o.x = pk2(s[0 * 33], s[1 * 33]); o.y = pk2(s[2 * 33], s[3 * 33]); o.z = pk2(s[4 * 33], s[5 * 33]); o.w = pk2(s[6 * 33], s[7 * 33]);
        *(v4u*)(WT + (size_t)(n0 + n) * K + k0 + 8 * c) = o; }
    LDS_WAIT(); asm volatile("" ::: "memory");
}

#define FLANE lane_id()
#define FTID (F.wave * 64 + lane_id())
struct Frame {
    LAS unsigned char* lds; char* ldsg;
    volatile LAS unsigned* MISC;
    gu32* ctl;
    int wave, G;
    const float* const* in;
    float* out;
    unsigned char* ws;
};
#define IN_X 0
#define IN_MEM 1
#define IN_REL 2
#define IN_GMIX 3
#define IN_WIN 4
#define IN_GGRP 5
#define IN_SINK 6
#define IN_WOUT 7
#define IN_GCROSS 8
#define IN_GMEM 9
#define IN_WXQ 10
#define IN_WXKV 11
#define IN_WXO 12
#define IN_GMLP 13
#define IN_WUP 14
#define IN_WDOWN 15
#define IN_GFINAL 16

__device__ __forceinline__ void p0_prologue(Frame& F) {
    LAS float* scr = (LAS float*)(F.lds + RING_OFF + F.wave * 16384);
    const int gw = (int)blockIdx.x * NWAVES + F.wave, NGW = F.G * NWAVES;
    constexpr int I_IN = (D / 64) * (INW / 32), I_OUT = (D / 64) * (D / 32), I_XQ = (D / 64) * (XW / 32), I_XKV = (D / 64) * (512 / 32), I_XO = (XW / 64) * (D / 32), I_UP = (D / 64) * (FF / 32), I_DOWN = (FF / 64) * (D / 32);
    constexpr int I_LAYER = I_IN + I_OUT + I_XQ + I_XKV + I_XO + I_UP + I_DOWN;
    {
        bf16* XB = (bf16*)(F.ws + WS_XB); float* ssq = (float*)(F.ws + WS_SSQ);
        constexpr int RB = 4;
        for (int k = 0; ; ++k) {
            const int m0 = gw + k * RB * NGW, it = gw + k * NGW;
            const bool hx = m0 < M, hw = it < DEPTH * I_LAYER;
            if (!hx && !hw) break;
            f32x4 v[RB][4];
            if (hx) {
#pragma unroll
                for (int r = 0; r < RB; ++r) { const f32x4* xr = (const f32x4*)(F.in[IN_X] + (size_t)(m0 + r * NGW) * D) + FLANE;
#pragma unroll
                    for (int j = 0; j < 4; ++j) v[r][j] = xr[64 * j]; }
            }
            if (hw) {
                const int l = it / I_LAYER; int r = it % I_LAYER;
                unsigned char* wl = F.ws + WS_W + (size_t)l * W_LAYER;
                const float* W; int K, N; bf16* WT; const float* g; unsigned qm = 0u;
                if (r < I_IN) { W = F.in[IN_WIN] + (size_t)l * D * INW; K = D; N = INW; WT = (bf16*)(wl + WO_IN); g = F.in[IN_GMIX] + l * D; qm = (1u << 0) | (1u << 3) | (1u << 6) | (1u << 8); }
                else if ((r -= I_IN) < I_OUT) { W = F.in[IN_WOUT] + (size_t)l * D * D; K = D; N = D; WT = (bf16*)(wl + WO_OUT); g = F.in[IN_GGRP] + l * D; }
                else if ((r -= I_OUT) < I_XQ) { W = F.in[IN_WXQ] + (size_t)l * D * XW; K = D; N = XW; WT = (bf16*)(wl + WO_XQ); g = F.in[IN_GCROSS] + l * D; qm = 1u; }
                else if ((r -= I_XQ) < I_XKV) { W = F.in[IN_WXKV] + (size_t)l * D * 512; K = D; N = 512; WT = (bf16*)(F.ws + WS_WXKV) + (size_t)l * 512 * D; g = F.in[IN_GMEM] + l * D; }
                else if ((r -= I_XKV) < I_XO) { W = F.in[IN_WXO] + (size_t)l * XW * D; K = XW; N = D; WT = (bf16*)(wl + WO_XO); g = nullptr; }
                else if ((r -= I_XO) < I_UP) { W = F.in[IN_WUP] + (size_t)l * D * FF; K = D; N = FF; WT = (bf16*)(wl + WO_UP); g = F.in[IN_GMLP] + l * D; }
                else { r -= I_UP; W = F.in[IN_WDOWN] + (size_t)l * FF * D; K = FF; N = D; WT = (bf16*)(wl + WO_DOWN); g = nullptr; }
                p0_transpose_item(W, K, N, WT, g, qm, scr, r, FLANE);
            }
            if (hx) {
#pragma unroll
                for (int r = 0; r < RB; ++r) { const int m = m0 + r * NGW; float s = 0.f;
#pragma unroll
                    for (int j = 0; j < 4; ++j) s += (v[r][j].x * v[r][j].x + v[r][j].y * v[r][j].y) + (v[r][j].z * v[r][j].z + v[r][j].w * v[r][j].w);
                    s = wave_sum(s);
                    unsigned long long* o8 = (unsigned long long*)(XB + (size_t)m * D) + FLANE;
#pragma unroll
                    for (int j = 0; j < 4; ++j) o8[64 * j] = (unsigned long long)pk2(v[r][j].x, v[r][j].y) | ((unsigned long long)pk2(v[r][j].z, v[r][j].w) << 32);
                    if (FLANE < 16) ssq[(size_t)m * 16 + FLANE] = (FLANE == 0) ? s : 0.f; }
            }
        }
    }
    {
        bf16* MN = (bf16*)(F.ws + WS_MEMN);
        for (int m = gw; m < MROWS; m += NGW) {
            const f32x4* xr = (const f32x4*)(F.in[IN_MEM] + (size_t)m * D) + FLANE;
            f32x4 v[4]; float s = 0.f;
#pragma unroll
            for (int j = 0; j < 4; ++j) { v[j] = xr[64 * j]; s += (v[j].x * v[j].x + v[j].y * v[j].y) + (v[j].z * v[j].z + v[j].w * v[j].w); }
            const float rs = 1.0f / sqrtf(wave_sum(s) * (1.0f / D) + NORM_EPS);
            unsigned long long* o8 = (unsigned long long*)(MN + (size_t)m * D) + FLANE;
#pragma unroll
            for (int j = 0; j < 4; ++j) o8[64 * j] = (unsigned long long)pk2(v[j].x * rs, v[j].y * rs) | ((unsigned long long)pk2(v[j].z * rs, v[j].w * rs) << 32);
        }
    }
    {
        float* bt = (float*)(F.ws + WS_BT);
        for (int i = (int)blockIdx.x * (NWAVES * 64) + FTID; i < 12 * 2049; i += F.G * NWAVES * 64) {
            const int hh = i / 2049, dist = i % 2049;
            bt[hh * BT_STRIDE + dist] = F.in[IN_REL][rel_bucket(dist) * 12 + hh] * LOG2E;
        }
    }
}
namespace att {
using bf16x8 = __attribute__((ext_vector_type(8))) short;
using s16x4 = __attribute__((ext_vector_type(4))) short;
using f32x16 = __attribute__((ext_vector_type(16))) float;
using u32x4 = __attribute__((ext_vector_type(4))) unsigned;
typedef short v4i16_t __attribute__((ext_vector_type(4)));
typedef float f32x2_t __attribute__((ext_vector_type(2))); typedef __bf16 bf16x2_t __attribute__((ext_vector_type(2)));
typedef __attribute__((address_space(3))) const char* lds_cptr;
constexpr int SLOTB = 8192, NSLOT = 4, NSLOT_RES = 6;
constexpr int L_K = 0, L_V = NSLOT_RES * SLOTB, L_WS = 2 * NSLOT_RES * SLOTB, L_OST = L_WS + 8 * 256, L_TBS = L_OST + 8 * 4096, TB_PAD = 128, L_FLG = L_TBS + 2048, L_TBA = L_FLG + 256, L_END = L_TBA + 3 * 2048;
constexpr int L_TBD = L_TBS, L_KM = L_WS, TB_MAXLEN = 2048 + 2 * TB_PAD + 16;
static_assert(L_END <= 143360 && L_TBD + TB_MAXLEN * 4 <= 143360 && L_KM + 2048 <= L_OST && (128 + 2 * TB_PAD + 1) * 4 <= 2048, "attention LDS map");
constexpr float NEGB = -1e30f;
__device__ __forceinline__ int crow(int r, int hi) { return (r & 3) + 8 * (r >> 2) + 4 * hi; }
#define ASBAR() __builtin_amdgcn_sched_barrier(0)
__device__ __forceinline__ void glds16(const void* gsrc, unsigned lds_dst) { unsigned keep;
    asm volatile("s_mov_b32 %0, m0\n\ts_mov_b32 m0, %2\n\ts_nop 0\n\tglobal_load_lds_dwordx4 %1, off\n\ts_mov_b32 m0, %0" : "=&s"(keep) : "v"(gsrc), "s"(lds_dst) : "memory"); }
__device__ __forceinline__ unsigned cvtpk_s(float lo, float hi) { f32x2_t v = {lo, hi}; bf16x2_t b = __builtin_convertvector(v, bf16x2_t); return __builtin_bit_cast(unsigned, b); }
#define AWAIT_BAR(N) asm volatile("s_waitcnt vmcnt(" #N ") lgkmcnt(0)\n\ts_barrier" ::: "memory")
__device__ __forceinline__ float xhalf(float v) { return __shfl_xor(v, 32); }

__device__ __forceinline__ void qkt(f32x16& p0, f32x16& p1, lds_cptr Kslot, const bf16x8* qr, float c0, int r32, int hi) {
    lds_cptr kb = Kslot + hi * 1024 + r32 * 16;
#pragma unroll
    for (int r = 0; r < 16; ++r) { p0[r] = c0; p1[r] = c0; }
#pragma unroll
    for (int d0 = 0; d0 < 4; ++d0) {
        const bf16x8 b0 = *(const __attribute__((address_space(3))) bf16x8*)(kb + d0 * 2048);
        const bf16x8 b1 = *(const __attribute__((address_space(3))) bf16x8*)(kb + d0 * 2048 + 512);
        p0 = __builtin_amdgcn_mfma_f32_32x32x16_bf16(b0, qr[d0], p0, 0, 0, 0); p1 = __builtin_amdgcn_mfma_f32_32x32x16_bf16(b1, qr[d0], p1, 0, 0, 0); }
}
__device__ __forceinline__ s16x4 vtr(lds_cptr p) { return __builtin_bit_cast(s16x4, __builtin_amdgcn_ds_read_tr16_b64_v4i16((__attribute__((address_space(3))) v4i16_t*)p)); }
__device__ __forceinline__ void pv(f32x16* o, lds_cptr vp, const u32x4* pw) {
#pragma unroll
    for (int d0 = 0; d0 < 2; ++d0) {
#pragma unroll
        for (int ks = 0; ks < 4; ++ks) {
            const s16x4 lo = vtr(vp + d0 * 4096 + ks * 1024), hi = vtr(vp + d0 * 4096 + ks * 1024 + 512);
            const bf16x8 vf = (bf16x8){lo[0], lo[1], lo[2], lo[3], hi[0], hi[1], hi[2], hi[3]};
            o[d0] = __builtin_amdgcn_mfma_f32_32x32x16_bf16(__builtin_bit_cast(bf16x8, pw[ks]), vf, o[d0], 0, 0, 0); }
    }
}

__device__ __forceinline__ void kload(bf16x8* kf, lds_cptr Kslot, int r32, int hi) {
    lds_cptr kb = Kslot + r32 * 128;
    const int x = (hi << 4) ^ (((r32 >> 1) & 7) << 4);
#pragma unroll
    for (int d0 = 0; d0 < 4; ++d0) { lds_cptr p = kb + (x ^ (d0 << 5)); kf[2 * d0] = *(const __attribute__((address_space(3))) bf16x8*)(p); kf[2 * d0 + 1] = *(const __attribute__((address_space(3))) bf16x8*)(p + 4096); }
}
__device__ __forceinline__ void vload(s16x4* vlo, s16x4* vhi, lds_cptr vp, lds_cptr vq) {
#pragma unroll
    for (int i = 0; i < 8; ++i) { lds_cptr b = (i >> 2) ? vq : vp; vlo[i] = vtr(b + (i & 3) * 2048); vhi[i] = vtr(b + (i & 3) * 2048 + 1024); }
}
__device__ __forceinline__ int vbase(int lane, int hi, int dh) { const int rl = 4 * hi + ((lane & 15) >> 2); return rl * 128 + ((dh ^ ((rl >> 1) & 1)) << 6) + ((lane >> 4) & 1) * 32 + (lane & 3) * 8; }
__device__ __forceinline__ void qkt_r(f32x16& p0, f32x16& p1, const bf16x8* kf, const bf16x8* qr, float c0) {
#pragma unroll
    for (int r = 0; r < 16; ++r) { p0[r] = c0; p1[r] = c0; }
#pragma unroll
    for (int d0 = 0; d0 < 4; ++d0) { p0 = __builtin_amdgcn_mfma_f32_32x32x16_bf16(kf[2 * d0], qr[d0], p0, 0, 0, 0); p1 = __builtin_amdgcn_mfma_f32_32x32x16_bf16(kf[2 * d0 + 1], qr[d0], p1, 0, 0, 0); }
}
__device__ __forceinline__ void pv_r(f32x16* o, const s16x4* vlo, const s16x4* vhi, const u32x4* pw) {
#pragma unroll
    for (int d0 = 0; d0 < 2; ++d0)
#pragma unroll
        for (int ks = 0; ks < 4; ++ks) { const int i = d0 * 4 + ks;
            const bf16x8 vf = (bf16x8){vlo[i][0], vlo[i][1], vlo[i][2], vlo[i][3], vhi[i][0], vhi[i][1], vhi[i][2], vhi[i][3]};
            o[d0] = __builtin_amdgcn_mfma_f32_32x32x16_bf16(__builtin_bit_cast(bf16x8, pw[ks]), vf, o[d0], 0, 0, 0); }
}
__device__ __forceinline__ void pack_p(u32x4* pw, const f32x16& p0, const f32x16& p1) {
    pw[0] = (u32x4){cvtpk_s(p0[0], p0[1]), cvtpk_s(p0[2], p0[3]), cvtpk_s(p0[4], p0[5]), cvtpk_s(p0[6], p0[7])};
    pw[1] = (u32x4){cvtpk_s(p0[8], p0[9]), cvtpk_s(p0[10], p0[11]), cvtpk_s(p0[12], p0[13]), cvtpk_s(p0[14], p0[15])};
    pw[2] = (u32x4){cvtpk_s(p1[0], p1[1]), cvtpk_s(p1[2], p1[3]), cvtpk_s(p1[4], p1[5]), cvtpk_s(p1[6], p1[7])};
    pw[3] = (u32x4){cvtpk_s(p1[8], p1[9]), cvtpk_s(p1[10], p1[11]), cvtpk_s(p1[12], p1[13]), cvtpk_s(p1[14], p1[15])};
}
__device__ __forceinline__ void build_table(char* shm, int ltb, const float* gt, int dmin, int dmax, int dscale, int tid) {
    float* R = (float*)(shm + ltb); const int OFF = dmax + TB_PAD, len = dmax + 2 * TB_PAD + 1;
    for (int k = tid; k < len; k += 512) { const int dist = OFF - k; R[k] = (dist >= dmin && dist <= dmax) ? gt[dist * dscale] : NEGB; }
}
__device__ __forceinline__ void dma_tile(const bf16* krow0, const bf16* vrow0, long rs, unsigned lds0, int slot, int wid, int lane, int lk = L_K, int lv = L_V) {
    const int krow = 8 * wid + (lane >> 3), kchunk = (lane & 7) ^ ((krow >> 1) & 7);
    const bf16* ksrc = krow0 + (long)krow * rs + kchunk * 8;
    const int vrow = 8 * wid + (lane >> 3), vchunk = (lane & 7) ^ (((vrow >> 1) & 1) << 2);
    const bf16* vsrc = vrow0 + (long)vrow * rs + vchunk * 8;
    glds16(ksrc, (unsigned)__builtin_amdgcn_readfirstlane(lds0 + lk + slot * SLOTB + wid * 1024));
    glds16(vsrc, (unsigned)__builtin_amdgcn_readfirstlane(lds0 + lv + slot * SLOTB + wid * 1024));
}
template <class RowPtr, class SsqPtr> __device__ __forceinline__ void store_o(char* shm, const f32x16* o, const float* rsc  , int wid, int lane, int r32, int hi, const RowPtr& orow, const SsqPtr& ssqp, int lost = L_OST) {
    bf16* stg = (bf16*)(shm + lost) + wid * 2048;
#pragma unroll
    for (int r = 0; r < 16; ++r) { const int q = crow(r, hi);
#pragma unroll
        for (int d0 = 0; d0 < 2; ++d0) stg[q * 64 + d0 * 32 + r32] = (bf16)f2bf(o[d0][r] * rsc[r]); }
    asm volatile("s_waitcnt lgkmcnt(0)" ::: "memory");
#pragma unroll
    for (int i = 0; i < 4; ++i) { const int row = i * 8 + (lane >> 3), ch = lane & 7; const u32x4 v = *(const u32x4*)(stg + row * 64 + ch * 8); *(u32x4*)(orow(row) + ch * 8) = v;
        float* sp = ssqp(row);
        if (sp) { float ss = 0.f;
#pragma unroll
            for (int e = 0; e < 4; ++e) { const float lo = __builtin_bit_cast(float, v[e] << 16), hf = __builtin_bit_cast(float, v[e] & 0xffff0000u); ss += lo * lo + hf * hf; }
            ss += __shfl_xor(ss, 1); ss += __shfl_xor(ss, 2); ss += __shfl_xor(ss, 4);
            if (ch == 0) *sp = ss; } }
}

template <class Pol> __device__ __forceinline__ void unit_issue_kv(const Pol& P, unsigned lds0, int wid, int lane) {
    const int NT = P.ntiles(), T0 = P.first_tile(); const long rs = P.rs();
    if (Pol::RES) {
#pragma nounroll
        for (int t = T0; t < NT; ++t) { const bf16 *kp, *vp; P.tile_ptrs(t, kp, vp); dma_tile(kp, vp, rs, lds0, t - T0, wid, lane); }
    } else if (Pol::PAIR) {
#pragma unroll
      for (int t = 0; t < 4; ++t) { const bf16 *kp, *vp; P.tile_ptrs(T0 + t, kp, vp); dma_tile(kp, vp, rs, lds0, t, wid, lane); }
    } else {
      const bf16 *kp, *vp; P.tile_ptrs(T0, kp, vp); dma_tile(kp, vp, rs, lds0, 0, wid, lane);
      if (T0 + 1 < NT) { P.tile_ptrs(T0 + 1, kp, vp); dma_tile(kp, vp, rs, lds0, 1, wid, lane); } }
}
template <class Pol> __device__ __forceinline__ void unit_issue_q(const Pol& P, unsigned lds0, int wid, int lane) {
#pragma unroll
    for (int j = 0; j < 4; ++j) { const int qrow = 8 * j + (lane >> 3), qch = (lane & 7) ^ ((qrow >> 1) & 7);
        glds16(P.q_row(wid, qrow) + qch * 8, (unsigned)__builtin_amdgcn_readfirstlane(lds0 + L_OST + wid * 4096 + j * 1024)); }
}
template <class Pol, class PolX> __device__ __forceinline__ void softmax_unit(const Pol& P, const Pol& Pn, const bool has_next, const PolX& Px, const bool has_other, const bool pre, bf16x8 (&qn)[4], char* shm, int& tkey, const int wid) {
    const int lane = lane_id(), tid = wid * 64 + lane, r32 = lane & 31, hi = lane >> 5;
    const unsigned lds0 = (unsigned)(uintptr_t)shm;
    float* wsf = (float*)(shm + L_WS) + wid * 64;
    const lds_cptr shm3 = (lds_cptr)shm;
    const lds_cptr vp0 = shm3 + L_V + vbase(lane, hi, 0), vq0 = shm3 + L_V + vbase(lane, hi, 1);
    const int NT = P.ntiles(), T0 = P.first_tile();
    const long rs = P.rs();
    if (!pre) {
        const typename Pol::Pre pr = P.setup_load(tid);
        P.setup_commit(pr, shm, tid, tkey);
        unit_issue_kv(P, lds0, wid, lane);
        unit_issue_q(P, lds0, wid, lane);
    }
    AWAIT_BAR(0);
    bf16x8 qr[4];
    if (pre) {
#pragma unroll
        for (int d0 = 0; d0 < 4; ++d0) qr[d0] = qn[d0];
    } else { lds_cptr qb = shm3 + L_OST + wid * 4096 + r32 * 128; const int x = (hi << 4) ^ (((r32 >> 1) & 7) << 4);
#pragma unroll
      for (int d0 = 0; d0 < 4; ++d0) qr[d0] = *(const __attribute__((address_space(3))) bf16x8*)(qb + (x ^ (d0 << 5))); }
    asm volatile("s_waitcnt lgkmcnt(0)" : "+v"(qr[0]), "+v"(qr[1]), "+v"(qr[2]), "+v"(qr[3]) :: "memory");
    typename Pol::Lane LS; P.prepare(LS, shm, qr, wid, lane, r32, hi);
    float mrun = P.m_init(LS), lrun = P.l_init(LS, hi);
    f32x16 o[2]; o[0] = f32x16{}; o[1] = f32x16{};
    int slot = 0;
    const bool defer = !Pol::RES && !Pol::PAIR && wid >= 4; bool pend = false; int pslot = 0; u32x4 pwp[4];
    bf16x8 kfa[8], kfb[8]; bool havek = false;
    auto tile_body = [&](const int idx, bf16x8* kf, bf16x8* kfn) __attribute__((always_inline)) {
        if (P.uses(LS, idx, wid)) {
            f32x16 p0, p1; s16x4 vlo[8], vhi[8]; float tb0[16], tb1[16];
            if (!(Pol::RES && havek)) kload(kf, shm3 + L_K + slot * SLOTB, r32, hi);
            const bool inited = mrun > -1e29f;
            const float cref = inited ? mrun : 0.f;
            float c0 = P.rowneg(LS, idx) - cref;
            bool tbl = Pol::HAS_TABLE;
            if (Pol::HAS_TABLE) {
                float cb;
                if (P.const_bias(LS, idx, wid, (const float*)(shm + P.ltb()), cb)) { c0 += cb; tbl = false; }
                else {
                    const float* R = (const float*)(shm + P.ltb()) + (P.tb_off() - P.dist0(LS, idx, wid, r32)) + 4 * hi;
#pragma unroll
                    for (int r = 0; r < 16; ++r) { const int c = (r & 3) + 8 * (r >> 2); tb0[r] = R[c]; tb1[r] = R[c + 32]; }
                }
            }
            ASBAR();
            qkt_r(p0, p1, kf, qr, c0);
            ASBAR();
            if (!defer) vload(vlo, vhi, vp0 + slot * SLOTB, vq0 + slot * SLOTB);
            havek = false;
            if (Pol::RES) { if (idx + 1 < NT && P.uses(LS, idx + 1, wid)) { kload(kfn, shm3 + L_K + (slot + 1) * SLOTB, r32, hi); havek = true; } }
            ASBAR();
            if (tbl) {
#pragma unroll
                for (int r = 0; r < 16; ++r) { p0[r] += tb0[r]; p1[r] += tb1[r]; }
            }
            float rm = __builtin_fmaxf(p0[0], p1[0]);
#pragma unroll
            for (int r = 1; r < 16; ++r) rm = __builtin_fmaxf(__builtin_fmaxf(rm, p0[r]), p1[r]);
            rm = __builtin_fmaxf(rm, xhalf(rm));
            const bool need = (rm > 8.0f) || !inited;
            if (__any(need)) {
                const float dl = need ? rm : 0.f;
                const float mnew = cref + dl;
                const float f = need ? ex2(mrun - mnew) : 1.0f;
                mrun = need ? mnew : mrun;
#pragma unroll
                for (int r = 0; r < 16; ++r) { p0[r] -= dl; p1[r] -= dl; }
                lrun *= f;
                if (hi == 0) wsf[r32] = f;
                asm volatile("s_waitcnt lgkmcnt(0)" ::: "memory");
#pragma unroll
                for (int r = 0; r < 16; ++r) { const float fr = wsf[crow(r, hi)]; o[0][r] *= fr; o[1][r] *= fr; }
            }
            float rsum = 0.f;
#pragma unroll
            for (int r = 0; r < 16; ++r) { p0[r] = ex2(p0[r]); p1[r] = ex2(p1[r]); rsum += p0[r] + p1[r]; }
            lrun += rsum;
            u32x4 pw[4]; pack_p(pw, p0, p1);
            if (defer) { pwp[0] = pw[0]; pwp[1] = pw[1]; pwp[2] = pw[2]; pwp[3] = pw[3]; pslot = slot; pend = true; }
            else pv_r(o, vlo, vhi, pw);
        }
    };
    if (Pol::RES) {
        for (int idx = T0; idx < NT; idx += 2) {
            tile_body(idx, kfa, kfb); ++slot;
            if (idx + 1 < NT) { tile_body(idx + 1, kfb, kfa); ++slot; }
        }
    } else {
    for (int idx = T0; idx < NT; ++idx) {
        if (!Pol::RES) {
            if (Pol::PAIR) {
                if (((idx - T0) & 1) == 0) {
                    if (idx + 2 < NT) { AWAIT_BAR(4); } else { AWAIT_BAR(0); }
                    if (idx + 4 < NT) { const bf16 *kp, *vp; const int s4 = slot + 4 >= 6 ? slot - 2 : slot + 4;
                                        P.tile_ptrs(idx + 4, kp, vp); dma_tile(kp, vp, rs, lds0, s4, wid, lane);
                                        P.tile_ptrs(idx + 5, kp, vp); dma_tile(kp, vp, rs, lds0, s4 + 1, wid, lane); }
                }
            } else {
                if (idx + 1 < NT) { AWAIT_BAR(2); } else { AWAIT_BAR(0); }
                if (idx + 2 < NT) { const bf16 *kp, *vp; P.tile_ptrs(idx + 2, kp, vp); dma_tile(kp, vp, rs, lds0, (slot + 2) & 3, wid, lane); }
            }
        }
        if (pend) { s16x4 vlo[8], vhi[8]; vload(vlo, vhi, vp0 + pslot * SLOTB, vq0 + pslot * SLOTB); pv_r(o, vlo, vhi, pwp); pend = false; }
        tile_body(idx, kfa, kfb);
        slot = Pol::PAIR ? (slot + 1 == 6 ? 0 : slot + 1) : ((slot + 1) & 3);
    }
    }
    if (pend) { s16x4 vlo[8], vhi[8]; vload(vlo, vhi, vp0 + pslot * SLOTB, vq0 + pslot * SLOTB); pv_r(o, vlo, vhi, pwp); }
    lrun += xhalf(lrun);
    P.finish(LS, mrun, lrun, wid, r32, hi);
    if (hi == 0) wsf[32 + r32] = 1.0f / lrun;
    asm volatile("s_waitcnt lgkmcnt(0)" ::: "memory");
    float rli[16];
#pragma unroll
    for (int r = 0; r < 16; ++r) rli[r] = wsf[32 + crow(r, hi)];
    if (has_next) {
#pragma unroll
        for (int d0 = 0; d0 < 4; ++d0) qn[d0] = *(const bf16x8*)(Pn.q_row(wid, r32) + d0 * 16 + hi * 8);
        const typename Pol::Pre pr = Pn.setup_load(tid);
        asm volatile("s_waitcnt lgkmcnt(0)\n\ts_barrier" ::: "memory");
        Pn.setup_commit(pr, shm, tid, tkey);
        unit_issue_kv(Pn, lds0, wid, lane);
    } else if (has_other) {
#pragma unroll
        for (int d0 = 0; d0 < 4; ++d0) qn[d0] = *(const bf16x8*)(Px.q_row(wid, r32) + d0 * 16 + hi * 8);
        const typename PolX::Pre pr = Px.setup_load(tid);
        asm volatile("s_waitcnt lgkmcnt(0)\n\ts_barrier" ::: "memory");
        Px.setup_commit(pr, shm, tid, tkey);
        unit_issue_kv(Px, lds0, wid, lane);
    }
    store_o(shm, o, rli, wid, lane, r32, hi, [&](int row) { return P.o_row(wid, row); }, [&](int row) { return P.ssq_row(wid, row); });
    if (!has_next && !has_other) {
        asm volatile("s_waitcnt lgkmcnt(0)\n\ts_barrier" ::: "memory");
    }
}

struct LaneNone {};
struct PolD {
    static constexpr bool HAS_TABLE = true, RES = false, PAIR = true; static constexpr int LTB = L_TBD;
    struct Lane { unsigned sel, wavesel; };
    const bf16* proj; bf16* Y; const float* bt; const float* kmean; int b, h, qb;
    __device__ __forceinline__ int ntiles() const { return 4 * (qb + 1); }
    __device__ __forceinline__ int first_tile() const { return 0; }
    __device__ __forceinline__ long rs() const { return INW; }
    __device__ __forceinline__ int tb_off() const { return 2047 + TB_PAD; }
    struct Pre { float kmv; };
    __device__ __forceinline__ int ltb() const { return LTB; }
    __device__ __forceinline__ Pre setup_load(int tid) const {
        const float* kp = kmean + ((size_t)(b * 8 + (tid >> 6)) * 2) * 256 + h * 64 + (tid & 63); return Pre{(kp[0] + kp[256]) * (1.0f / 256.0f)}; }
    __device__ __forceinline__ void setup_commit(const Pre& pr, char* shm, int tid, int& tkey) const {
        if (tkey != 100 + h) { build_table(shm, LTB, bt + (8 + h) * BT_STRIDE, 0, 2047, 1, tid); tkey = 100 + h; }
        float* km = (float*)(shm + L_KM); km[tid] = pr.kmv;
    }
    __device__ __forceinline__ const bf16* q_row(int wid, int r32) const { return proj + ((size_t)b * SEQ + qb * 256 + wid * 32 + r32) * INW + COL_DQ + h * 64; }
    __device__ __forceinline__ bf16* o_row(int wid, int row) const { return Y + ((size_t)b * SEQ + qb * 256 + wid * 32 + row) * D + 768 + h * 64; }
    float* ssqy; __device__ __forceinline__ float* ssq_row(int wid, int row) const { return ssqy + ((size_t)b * SEQ + qb * 256 + wid * 32 + row) * 16 + 12 + h; }
    __device__ __forceinline__ void tile_ptrs(int idx, const bf16*& kp, const bf16*& vp) const { const bf16* r0 = proj + ((size_t)b * SEQ + idx * 64) * INW + h * 64; kp = r0 + COL_DK; vp = r0 + COL_DV; }
    __device__ __forceinline__ void prepare(Lane& L, char* shm, const bf16x8* qr, int wid, int lane, int r32, int hi) const {
        const float* km = (const float*)(shm + L_KM);
        float gate[8];
#pragma unroll
        for (int n = 0; n < 8; ++n) { float s = 0.f;
            if (n < qb) {
#pragma unroll
                for (int d0 = 0; d0 < 4; ++d0)
#pragma unroll
                    for (int e = 0; e < 8; ++e) s += __builtin_bit_cast(float, (unsigned)(unsigned short)qr[d0][e] << 16) * km[n * 64 + d0 * 16 + hi * 8 + e];
                s += xhalf(s);
            }
            gate[n] = (n < qb) ? s : -3e38f; }
        unsigned sel = 0u;
#pragma unroll
        for (int n = 0; n < 8; ++n) { int rank = 0;
#pragma unroll
            for (int n2 = 0; n2 < 8; ++n2) rank += (n2 != n) && ((gate[n2] > gate[n]) || (gate[n2] == gate[n] && n2 < n));
            if (n < qb && rank < 3) sel |= 1u << n; }
        unsigned ws = 0u;
#pragma unroll
        for (int n = 0; n < 8; ++n) ws |= (__ballot((sel >> n) & 1u) != 0ull) ? (1u << n) : 0u;
        L.sel = sel; L.wavesel = ws;
    }
    __device__ __forceinline__ bool uses(const Lane& L, int idx, int wid) const { const int blk = idx >> 2; return blk == qb ? ((idx & 3) * 64 <= wid * 32 + 31) : ((L.wavesel >> blk) & 1u); }
    __device__ __forceinline__ float rowneg(const Lane& L, int idx) const { const int blk = idx >> 2; return (blk == qb || ((L.sel >> blk) & 1u)) ? 0.f : NEGB; }
    __device__ __forceinline__ bool const_bias(const Lane&, int idx, int wid, const float* R, float& cb) const {
        const int dlo = qb * 256 + wid * 32 - idx * 64 - 63;
        const unsigned d = (unsigned)dlo;
        const bool one = (d - 332u <= 23u) | (d - 450u <= 64u) | (d - 609u <= 121u) | (d - 825u <= 197u) | (d - 1117u <= 301u) | (dlo >= 1513);
        if ((idx >> 2) >= qb || dlo < 16 || !one) return false;
        cb = R[tb_off() - dlo]; return true; }
    __device__ __forceinline__ int dist0(const Lane&, int idx, int wid, int r32) const { return qb * 256 + wid * 32 + r32 - idx * 64; }
    __device__ __forceinline__ float m_init(const Lane&) const { return NEGB; }
    __device__ __forceinline__ float l_init(const Lane&, int) const { return 0.f; }
    __device__ __forceinline__ void finish(const Lane&, float, float, int, int, int) const {}
};

struct PolX {
    static constexpr bool HAS_TABLE = false, RES = true, PAIR = false; static constexpr int LTB = L_TBS;
    struct Lane {};
    const bf16* Q2; bf16* O2; const bf16* KV; int l, b, h, s;
    __device__ __forceinline__ int ntiles() const { return 4; }
    __device__ __forceinline__ int first_tile() const { return 0; }
    __device__ __forceinline__ long rs() const { return 1024; }
    __device__ __forceinline__ int tb_off() const { return 0; }
    struct Pre {}; __device__ __forceinline__ int ltb() const { return LTB; }
    __device__ __forceinline__ Pre setup_load(int) const { return Pre{}; }
    __device__ __forceinline__ void setup_commit(const Pre&, char*, int, int&) const {}
    __device__ __forceinline__ const bf16* q_row(int wid, int r32) const { return Q2 + ((size_t)b * SEQ + s * 256 + wid * 32 + r32) * XW + h * 64; }
    __device__ __forceinline__ bf16* o_row(int wid, int row) const { return O2 + ((size_t)b * SEQ + s * 256 + wid * 32 + row) * XW + h * 64; }
    __device__ __forceinline__ float* ssq_row(int, int) const { return nullptr; }
    __device__ __forceinline__ void tile_ptrs(int idx, const bf16*& kp, const bf16*& vp) const { kp = KV + ((size_t)b * MEMLEN + idx * 64) * 1024 + l * 512 + h * 64; vp = kp + 256; }
    __device__ __forceinline__ void prepare(Lane&, char*, const bf16x8*, int, int, int, int) const {}
    __device__ __forceinline__ bool uses(const Lane&, int, int) const { return true; }
    __device__ __forceinline__ float rowneg(const Lane&, int) const { return 0.f; }
    __device__ __forceinline__ bool const_bias(const Lane&, int, int, const float*, float&) const { return false; }
    __device__ __forceinline__ int dist0(const Lane&, int, int, int) const { return 0; }
    __device__ __forceinline__ float m_init(const Lane&) const { return NEGB; }
    __device__ __forceinline__ float l_init(const Lane&, int) const { return 0.f; }
    __device__ __forceinline__ void finish(const Lane&, float, float, int, int, int) const {}
};
struct PolC {
    static constexpr bool HAS_TABLE = true, RES = true, PAIR = false; static constexpr int LTB = L_TBS;
    struct Lane {};
    const bf16* proj; bf16* Y; const float* bt; float sink2; int b, h, s;
    __device__ __forceinline__ int ntiles() const { return 6; }
    __device__ __forceinline__ int first_tile() const { return s == 0 ? 2 : 0; }
    __device__ __forceinline__ long rs() const { return INW; }
    __device__ __forceinline__ int tb_off() const { return 127 + TB_PAD; }
    struct Pre {}; __device__ __forceinline__ int ltb() const { return LTB; }
    __device__ __forceinline__ Pre setup_load(int) const { return Pre{}; }
    __device__ __forceinline__ void setup_commit(const Pre&, char* shm, int tid, int& tkey) const { if (tkey != 300 + h) { build_table(shm, LTB, bt + (4 + h) * BT_STRIDE, 0, 127, 1, tid); tkey = 300 + h; } }
    __device__ __forceinline__ const bf16* q_row(int wid, int r32) const { return proj + ((size_t)b * SEQ + s * 256 + wid * 32 + r32) * INW + COL_CQ + h * 64; }
    __device__ __forceinline__ bf16* o_row(int wid, int row) const { return Y + ((size_t)b * SEQ + s * 256 + wid * 32 + row) * D + 512 + h * 64; }
    float* ssqy; __device__ __forceinline__ float* ssq_row(int wid, int row) const { return ssqy + ((size_t)b * SEQ + s * 256 + wid * 32 + row) * 16 + 8 + h; }
    __device__ __forceinline__ void tile_ptrs(int idx, const bf16*& kp, const bf16*& vp) const { const bf16* r0 = proj + ((size_t)b * SEQ + s * 256 - 128 + idx * 64) * INW + (h >> 1) * 64; kp = r0 + COL_CK; vp = r0 + COL_CV; }
    __device__ __forceinline__ void prepare(Lane&, char*, const bf16x8*, int, int, int, int) const {}
    __device__ __forceinline__ bool uses(const Lane&, int idx, int wid) const { const int iw = 128 + 32 * wid, j0 = 64 * idx; return j0 <= iw + 31 && j0 + 63 >= iw - 127; }
    __device__ __forceinline__ float rowneg(const Lane&, int) const { return 0.f; }
    __device__ __forceinline__ bool const_bias(const Lane&, int, int, const float*, float&) const { return false; }
    __device__ __forceinline__ int dist0(const Lane&, int idx, int wid, int r32) const { return 128 + 32 * wid + r32 - 64 * idx; }
    __device__ __forceinline__ float m_init(const Lane&) const { return sink2; }
    __device__ __forceinline__ float l_init(const Lane&, int hi) const { return hi == 0 ? 1.0f : 0.f; }
    __device__ __forceinline__ void finish(const Lane&, float, float, int, int, int) const {}
};
struct PolA {
    static constexpr bool HAS_TABLE = true, RES = true, PAIR = false; static constexpr int LTB = L_TBS;
    struct Lane {};
    const bf16* proj; bf16* Y; bf16* YA1; bf16* YA2; float* lse; const float* bt; int b, h, cfg, sub;
    __device__ __forceinline__ int dil() const { return cfg == 0 ? 1 : (cfg == 1 ? 4 : 16); }
    __device__ __forceinline__ int ntiles() const { return cfg == 2 ? 4 : 6; }
    __device__ __forceinline__ int first_tile() const { return cfg == 2 ? 0 : (((cfg == 0 ? sub : (sub & 1)) == 0) ? 2 : 0); }
    __device__ __forceinline__ long rs() const { return (long)dil() * INW; }
    __device__ __forceinline__ int tb_off() const { return 128 + TB_PAD; }
    struct Pre {}; __device__ __forceinline__ int ltb() const { return L_TBA + cfg * 2048; }
    __device__ __forceinline__ Pre setup_load(int) const { return Pre{}; }
    __device__ __forceinline__ void setup_commit(const Pre&, char* shm, int tid, int& tkey) const {
        if (tkey != 200 + h) { build_table(shm, L_TBA, bt + h * BT_STRIDE, 0, 128, 1, tid); build_table(shm, L_TBA + 2048, bt + h * BT_STRIDE, 0, 128, 4, tid);
                               build_table(shm, L_TBA + 4096, bt + h * BT_STRIDE, 0, 128, 16, tid); tkey = 200 + h; } }
    __device__ __forceinline__ int token(int wid, int r) const {
        if (cfg == 0) return sub * 256 + wid * 32 + r;
        if (cfg == 1) return (sub >> 1) + 4 * ((sub & 1) * 256 + wid * 32 + r);
        return (2 * sub + (wid >> 2)) + 16 * ((wid & 3) * 32 + r);
    }
    __device__ __forceinline__ const bf16* q_row(int wid, int r32) const { return proj + ((size_t)b * SEQ + token(wid, r32)) * INW + COL_AQ + h * 64; }
    __device__ __forceinline__ bf16* o_row(int wid, int row) const { const size_t t = (size_t)b * SEQ + token(wid, row);
        return cfg == 0 ? Y + t * D + h * 64 : (cfg == 1 ? YA1 : YA2) + t * 256 + h * 64; }
    __device__ __forceinline__ float* ssq_row(int, int) const { return nullptr; }
    __device__ __forceinline__ void tile_ptrs(int idx, const bf16*& kp, const bf16*& vp) const {
        int t0;
        if (cfg == 0) t0 = sub * 256 - 128 + idx * 64;
        else if (cfg == 1) t0 = (sub >> 1) + 4 * ((sub & 1) * 256 - 128 + idx * 64);
        else t0 = (2 * sub + (idx >> 1)) + 16 * ((idx & 1) * 64);
        const bf16* r0 = proj + ((size_t)b * SEQ + t0) * INW + h * 64; kp = r0 + COL_AK; vp = r0 + COL_AV; }
    __device__ __forceinline__ void prepare(Lane&, char*, const bf16x8*, int, int, int, int) const {}
    __device__ __forceinline__ bool uses(const Lane&, int idx, int wid) const {
        if (cfg == 2) return (idx >> 1) == (wid >> 2) && 64 * (idx & 1) <= 32 * (wid & 3) + 31;
        const int iw = 128 + 32 * wid, j0 = 64 * idx; return j0 <= iw + 31 && j0 + 63 >= iw - 128; }
    __device__ __forceinline__ float rowneg(const Lane&, int) const { return 0.f; }
    __device__ __forceinline__ bool const_bias(const Lane&, int, int, const float*, float&) const { return false; }
    __device__ __forceinline__ int dist0(const Lane&, int idx, int wid, int r32) const { return cfg == 2 ? (32 * (wid & 3) + r32 - 64 * (idx & 1)) : (128 + 32 * wid + r32 - 64 * idx); }
    __device__ __forceinline__ float m_init(const Lane&) const { return NEGB; }
    __device__ __forceinline__ float l_init(const Lane&, int) const { return 0.f; }
    __device__ __forceinline__ void finish(const Lane&, float m, float l, int wid, int r32, int hi) const {
        if (hi == 0) lse[((size_t)cfg * M + (size_t)b * SEQ + token(wid, r32)) * 4 + h] = m + lg2(l); }
};

struct PolNone {
    static constexpr bool RES = true, PAIR = false; struct Pre {};
    __device__ __forceinline__ int ntiles() const { return 0; }
    __device__ __forceinline__ int first_tile() const { return 0; }
    __device__ __forceinline__ long rs() const { return 0; }
    __device__ __forceinline__ void tile_ptrs(int, const bf16*& kp, const bf16*& vp) const { kp = nullptr; vp = nullptr; }
    __device__ __forceinline__ const bf16* q_row(int, int) const { return nullptr; }
    __device__ __forceinline__ Pre setup_load(int) const { return Pre{}; }
    __device__ __forceinline__ void setup_commit(const Pre&, char*, int, int&) const {}
};
struct PolSBNext {
    static constexpr bool RES = true, PAIR = false; struct Pre {};
    const bf16* proj; int b, h, s;
    __device__ __forceinline__ int ntiles() const { const int NT = 4 * s + 4; return NT < 6 ? NT : 6; }
    __device__ __forceinline__ int first_tile() const { return 0; }
    __device__ __forceinline__ long rs() const { return INW; }
    __device__ __forceinline__ void tile_ptrs(int k, const bf16*& kp, const bf16*& vp) const { const bf16* r0 = proj + ((size_t)b * SEQ + (size_t)(4 * s + 3 - k) * 64) * INW + h * 64; kp = r0 + COL_BK; vp = r0 + COL_BV; }
    __device__ __forceinline__ const bf16* q_row(int wid, int r32) const { return proj + ((size_t)b * SEQ + s * 256 + wid * 32 + r32) * INW + COL_BQ + h * 64; }
    __device__ __forceinline__ Pre setup_load(int) const { return Pre{}; }
    __device__ __forceinline__ void setup_commit(const Pre&, char*, int, int&) const {}
};

constexpr int SB_NR = 6, SB_LK = 0, SB_LV = SB_NR * SLOTB, SB_END = 2 * SB_NR * SLOTB;
static_assert(SB_NR == 6 && SB_LK == L_K && SB_LV == L_V, "PolSBNext requests the first unit's tiles through the resident-mode slot map");
static_assert(SB_END <= L_WS, "stick-breaking LDS map");
__device__ __forceinline__ void sb_unit(const bf16* proj, bf16* Y, float* ssqy, int b, int h, int s, int nb, int ns, const bool has_next, const bool pre, bf16x8 (&qn)[4], char* shm, const int wid) {
    const int lane = lane_id(), tid = wid * 64 + lane, r32 = lane & 31, hi = lane >> 5;
    const unsigned lds0 = (unsigned)(uintptr_t)shm;
    const lds_cptr shm3 = (lds_cptr)shm;
    const lds_cptr vp0 = shm3 + SB_LV + vbase(lane, hi, 0), vq0 = shm3 + SB_LV + vbase(lane, hi, 1);
    __attribute__((address_space(3))) unsigned* flg = (__attribute__((address_space(3))) unsigned*)(shm3 + L_FLG);
    const int NT = 4 * s + 4, NR = NT < SB_NR ? NT : SB_NR;
    const bf16* kbase = proj + (size_t)b * SEQ * INW + COL_BK + h * 64; const bf16* vbase = proj + (size_t)b * SEQ * INW + COL_BV + h * 64;
#define SB_TILE(idx) (4 * s + 3 - (idx))
#define SB_DMA(idx, slot) dma_tile(kbase + (size_t)SB_TILE(idx) * 64 * INW, vbase + (size_t)SB_TILE(idx) * 64 * INW, INW, lds0, (slot), wid, lane, SB_LK, SB_LV)
    bf16x8 qr[4];
    if (!pre) {
#pragma nounroll
        for (int k = 0; k < NR; ++k) SB_DMA(k, k);
        const bf16* Qrow = proj + ((size_t)b * SEQ + s * 256 + wid * 32 + r32) * INW + COL_BQ + h * 64;
#pragma unroll
        for (int d0 = 0; d0 < 4; ++d0) qr[d0] = *(const bf16x8*)(Qrow + d0 * 16 + hi * 8);
    } else {
#pragma unroll
        for (int d0 = 0; d0 < 4; ++d0) qr[d0] = qn[d0];
    }
    AWAIT_BAR(0);
    asm volatile("" : "+v"(qr[0]), "+v"(qr[1]), "+v"(qr[2]), "+v"(qr[3]));
    float carry = 1.0f; f32x16 o[2]; o[0] = f32x16{}; o[1] = f32x16{};
    const int iq = s * 256 + wid * 32 + r32;
    bool wdone = false;
#define SB_COMPUTE(slot_, j0_) do { \
        f32x16 p0, p1; bf16x8 kf[8]; s16x4 vlo[8], vhi[8]; \
        kload(kf, shm3 + SB_LK + (slot_) * SLOTB, r32, hi); \
        ASBAR(); \
        qkt_r(p0, p1, kf, qr, 0.f); \
        ASBAR(); \
        vload(vlo, vhi, vp0 + (slot_) * SLOTB, vq0 + (slot_) * SLOTB); \
        ASBAR(); \
        const bool diag = ((j0_) + 63 >= s * 256 + wid * 32); \
        const int dist0 = iq - (j0_) - 4 * hi; \
        if (diag) { _Pragma("unroll") for (int r = 0; r < 16; ++r) { const int c = (r & 3) + 8 * (r >> 2); if (dist0 - c < 1) p0[r] = -1e30f; if (dist0 - c - 32 < 1) p1[r] = -1e30f; } } \
          \
          \
        f32x2_t rr[16]; \
        _Pragma("unroll") for (int r = 0; r < 16; ++r) { f32x2_t w_ = (f32x2_t){ex2(p0[r]), ex2(p1[r])} + 1.0f; rr[r] = (f32x2_t){__builtin_amdgcn_rcpf(w_.x), __builtin_amdgcn_rcpf(w_.y)}; } \
        f32x2_t gsv[4], pgv[4]; \
        _Pragma("unroll") for (int g = 0; g < 4; ++g) gsv[g] = (rr[4 * g] * rr[4 * g + 1]) * (rr[4 * g + 2] * rr[4 * g + 3]); \
        _Pragma("unroll") for (int g = 0; g < 4; ++g) pgv[g] = (f32x2_t){xhalf(gsv[g].x), xhalf(gsv[g].y)}; \
          \
        float T[8]; float run = carry; \
        _Pragma("unroll") for (int g = 7; g >= 0; --g) { const float gsg = g >= 4 ? gsv[g & 3].y : gsv[g & 3].x, pgg = g >= 4 ? pgv[g & 3].y : pgv[g & 3].x; T[g] = hi == 0 ? run * pgg : run; run *= gsg * pgg; } \
          \
        f32x2_t a2[16]; \
        _Pragma("unroll") for (int g = 0; g < 4; ++g) { f32x2_t S = (f32x2_t){T[g], T[4 + g]}; \
            _Pragma("unroll") for (int i = 3; i >= 0; --i) { const f32x2_t Sn = S * rr[4 * g + i]; a2[4 * g + i] = S - Sn; S = Sn; } } \
        carry = run; \
        u32x4 pw[4]; \
        _Pragma("unroll") for (int q_ = 0; q_ < 2; ++q_) _Pragma("unroll") for (int e_ = 0; e_ < 4; ++e_) { \
            pw[q_][e_] = cvtpk_s(a2[8 * q_ + 2 * e_].x, a2[8 * q_ + 2 * e_ + 1].x); pw[2 + q_][e_] = cvtpk_s(a2[8 * q_ + 2 * e_].y, a2[8 * q_ + 2 * e_ + 1].y); } \
        pv_r(o, vlo, vhi, pw); \
        wdone = __all(carry < 0x1p-48f); \
    } while (0)
#pragma nounroll
    for (int k = 0; k < NR; ++k) {
        const int j0 = SB_TILE(k) * 64;
        if (!wdone && j0 < s * 256 + wid * 32 + 31) SB_COMPUTE(k, j0);
    }
    if (NT > NR) {
        if (lane == 0) flg[16 + wid] = wdone ? 1u : 0u;
        asm volatile("s_waitcnt lgkmcnt(0)\n\ts_barrier" ::: "memory");
        const unsigned alld = flg[16] & flg[17] & flg[18] & flg[19] & flg[20] & flg[21] & flg[22] & flg[23];
        if (!__builtin_amdgcn_readfirstlane(alld)) {
            SB_DMA(NR, 0);
            if (NR + 1 < NT) SB_DMA(NR + 1, 1);
            int slot = 0;
            for (int idx = NR; idx < NT; ++idx) {
                if (idx + 1 < NT) { AWAIT_BAR(2); } else { AWAIT_BAR(0); }
                if (idx > NR) { const __attribute__((address_space(3))) unsigned* f = flg + ((idx - 1) & 1) * 8; unsigned all = f[0] & f[1] & f[2] & f[3] & f[4] & f[5] & f[6] & f[7]; if (__builtin_amdgcn_readfirstlane(all)) break; }
                if (idx + 2 < NT) SB_DMA(idx + 2, (slot + 2) & 3);
                const int j0 = SB_TILE(idx) * 64;
                if (!wdone) SB_COMPUTE(slot, j0);
                if (lane == 0) flg[(idx & 1) * 8 + wid] = wdone ? 1u : 0u;
                slot = (slot + 1) & 3;
            }
            asm volatile("s_waitcnt vmcnt(0)" ::: "memory");
        }
    }
#undef SB_COMPUTE
#undef SB_DMA
#undef SB_TILE
    if (has_next) {
        const bf16* Qrow = proj + ((size_t)nb * SEQ + ns * 256 + wid * 32 + r32) * INW + COL_BQ + h * 64;
#pragma unroll
        for (int d0 = 0; d0 < 4; ++d0) qn[d0] = *(const bf16x8*)(Qrow + d0 * 16 + hi * 8);
    }
    asm volatile("s_waitcnt lgkmcnt(0)\n\ts_barrier" ::: "memory");
    if (has_next) {
        const int nNT = 4 * ns + 4, nNR = nNT < SB_NR ? nNT : SB_NR;
        const bf16* nk = proj + (size_t)nb * SEQ * INW + COL_BK + h * 64; const bf16* nv = proj + (size_t)nb * SEQ * INW + COL_BV + h * 64;
#pragma nounroll
        for (int k = 0; k < nNR; ++k) dma_tile(nk + (size_t)(4 * ns + 3 - k) * 64 * INW, nv + (size_t)(4 * ns + 3 - k) * 64 * INW, INW, lds0, k, wid, lane, SB_LK, SB_LV);
    }
    float one[16];
#pragma unroll
    for (int r = 0; r < 16; ++r) one[r] = 1.0f;
    store_o(shm, o, one, wid, lane, r32, hi, [&](int row) { return Y + ((size_t)b * SEQ + s * 256 + wid * 32 + row) * D + 256 + h * 64; },
            [&](int row) { return ssqy + ((size_t)b * SEQ + s * 256 + wid * 32 + row) * 16 + 4 + h; });
    if (!has_next) { asm volatile("s_waitcnt lgkmcnt(0)\n\ts_barrier" ::: "memory"); }
}
}
__device__ __forceinline__ void nm_merge(Frame& F) {
    bf16* Y = (bf16*)(F.ws + WS_Y); const bf16* YA1 = (const bf16*)(F.ws + WS_YA1); const bf16* YA2 = (const bf16*)(F.ws + WS_YA2); const float* lse = (const float*)(F.ws + WS_LSE);
    const float* ssqy = (const float*)(F.ws + WS_SSQY); float* rat = (float*)(F.ws + WS_RAT);
    const int gw = (int)blockIdx.x * NWAVES + F.wave, NGW = F.G * NWAVES;
    constexpr int RB = 4;
    for (int row0 = gw; row0 < M; row0 += RB * NGW) {
        unsigned long long w[RB], wa[RB], wc[RB]; float l0[RB], l1[RB], l2[RB], pp[RB];
#pragma unroll
        for (int j = 0; j < RB; ++j) { const int row = row0 + j * NGW;
            w[j] = *((const unsigned long long*)(Y + (size_t)row * D) + FLANE);
            const int hh = FLANE >> 4;
            l0[j] = lse[(size_t)row * 4 + hh]; l1[j] = lse[(size_t)(M + row) * 4 + hh]; l2[j] = lse[(size_t)(2 * M + row) * 4 + hh];
            wa[j] = *((const unsigned long long*)(YA1 + (size_t)row * 256) + FLANE); wc[j] = *((const unsigned long long*)(YA2 + (size_t)row * 256) + FLANE);
            pp[j] = ssqy[(size_t)row * 16 + (FLANE & 15)];
        }
#pragma unroll
        for (int j = 0; j < RB; ++j) { const int row = row0 + j * NGW;
            const unsigned long long ww = w[j];
            float v0 = bf_lo((unsigned)ww), v1 = bf_hi((unsigned)ww), v2 = bf_lo((unsigned)(ww >> 32)), v3 = bf_hi((unsigned)(ww >> 32));
            const float mx = __builtin_fmaxf(l0[j], __builtin_fmaxf(l1[j], l2[j]));
            const float w0 = ex2(l0[j] - mx), w1 = ex2(l1[j] - mx), w2 = ex2(l2[j] - mx), inv = 1.0f / (w0 + w1 + w2);
            const unsigned long long a = wa[j], c = wc[j];
            v0 = (w0 * v0 + w1 * bf_lo((unsigned)a) + w2 * bf_lo((unsigned)c)) * inv; v1 = (w0 * v1 + w1 * bf_hi((unsigned)a) + w2 * bf_hi((unsigned)c)) * inv;
            v2 = (w0 * v2 + w1 * bf_lo((unsigned)(a >> 32)) + w2 * bf_lo((unsigned)(c >> 32))) * inv; v3 = (w0 * v3 + w1 * bf_hi((unsigned)(a >> 32)) + w2 * bf_hi((unsigned)(c >> 32))) * inv;
            const unsigned p01 = pk2(v0, v1), p23 = pk2(v2, v3);
            __builtin_nontemporal_store((unsigned long long)p01 | ((unsigned long long)p23 << 32), (unsigned long long*)(Y + (size_t)row * D) + FLANE);
            const float r0 = bf_lo(p01), r1 = bf_hi(p01), r2 = bf_lo(p23), r3 = bf_hi(p23);
            const float ssA = wave_sum((r0 * r0 + r1 * r1) + (r2 * r2 + r3 * r3));
            float sg = pp[j]; sg += __shfl_xor(sg, 1); sg += __shfl_xor(sg, 2);
            const float ssB = __shfl(sg, 4), ssC = __shfl(sg, 8), ssD = __shfl(sg, 12);
            const float sA = 1.0f / sqrtf(ssA * (1.0f / 256.0f) + NORM_EPS), sB = 1.0f / sqrtf(ssB * (1.0f / 256.0f) + NORM_EPS);
            const float sC = 1.0f / sqrtf(ssC * (1.0f / 256.0f) + NORM_EPS), sD = 1.0f / sqrtf(ssD * (1.0f / 256.0f) + NORM_EPS);
            if (FLANE == 0) *(f32x4*)(rat + (size_t)row * 4) = f32x4{sA / sB, sB / sC, sC / sD, sD};
        }
    }
}
__device__ __forceinline__ void fn_finalnorm(Frame& F, const float* ssq) {
    const int gw = (int)blockIdx.x * NWAVES + F.wave, NGW = F.G * NWAVES;
    const f32x4* gf = (const f32x4*)F.in[IN_GFINAL] + FLANE;
    const bf16* XB = (const bf16*)(F.ws + WS_XB);
    f32x4 gv[4];
#pragma unroll
    for (int j = 0; j < 4; ++j) gv[j] = gf[64 * j];
    constexpr int RB = 4;
    for (int row0 = gw; row0 < M; row0 += RB * NGW) {
        unsigned long long w[RB][4]; float s[RB];
#pragma unroll
        for (int r = 0; r < RB; ++r) { const int row = row0 + r * NGW;
            s[r] = (FLANE < 16) ? ssq[(size_t)row * 16 + FLANE] : 0.f;
            const unsigned long long* xr = (const unsigned long long*)(XB + (size_t)row * D) + FLANE;
#pragma unroll
            for (int j = 0; j < 4; ++j) w[r][j] = xr[64 * j]; }
#pragma unroll
        for (int r = 0; r < RB; ++r) { const int row = row0 + r * NGW;
            const float rs = 1.0f / sqrtf(wave_sum(s[r]) * (1.0f / D) + NORM_EPS);
            f32x4* orow = (f32x4*)(F.out + (size_t)row * D) + FLANE;
#pragma unroll
            for (int j = 0; j < 4; ++j) { const unsigned long long ww = w[r][j];
                f32x4 v = {bf_lo((unsigned)ww), bf_hi((unsigned)ww), bf_lo((unsigned)(ww >> 32)), bf_hi((unsigned)(ww >> 32))};
                __builtin_nontemporal_store(v * rs * gv[j], orow + 64 * j); } }
    }
}
__device__ __forceinline__ void at_phase(Frame& F, int l) {
    const bf16* proj = (const bf16*)(F.ws + WS_PROJ); bf16* Y = (bf16*)(F.ws + WS_Y); const float* bt = (const float*)(F.ws + WS_BT); const float* kmean = (const float*)(F.ws + WS_KMEAN);
    const float* sinks = F.in[IN_SINK] + l * 4;
    float* ssqy = (float*)(F.ws + WS_SSQY);
    char* shm = F.ldsg + RING_OFF;
    const int G = F.G, cwg = (int)blockIdx.x, x = cwg & 7, q = cwg >> 3, gidx = q >> 3, j = q & 7;
    int tkey = -1;
    pg8::bf16x8 qn[4];
    if (G == 256) {
#pragma nounroll
    for (int i = 0; i < 4; ++i) {
        att::PolD P{proj, Y, bt, kmean, i * 8 + x, gidx, (i & 1) ? (7 - j) : j, ssqy};
        att::PolD Pn{proj, Y, bt, kmean, ((i + 1) & 3) * 8 + x, gidx, ((i + 1) & 1) ? (7 - j) : j, ssqy};
        att::PolA PA0{proj, Y, (bf16*)(F.ws + WS_YA1), (bf16*)(F.ws + WS_YA2), (float*)(F.ws + WS_LSE), bt, x, gidx, 0, j};
        att::softmax_unit(P, Pn, i + 1 < 4, PA0, i + 1 == 4, i > 0, qn, shm, tkey, F.wave);
    }
#pragma nounroll
    for (int i = 0; i < 12; ++i) {
        att::PolA P{proj, Y, (bf16*)(F.ws + WS_YA1), (bf16*)(F.ws + WS_YA2), (float*)(F.ws + WS_LSE), bt, (i / 3) * 8 + x, gidx, i % 3, j};
        const int i1 = i + 1 < 12 ? i + 1 : 0;
        att::PolA Pn{proj, Y, (bf16*)(F.ws + WS_YA1), (bf16*)(F.ws + WS_YA2), (float*)(F.ws + WS_LSE), bt, (i1 / 3) * 8 + x, gidx, i1 % 3, j};
        const int hc0 = 2 * (x & 1) + ((q >> 3) & 1);
        att::PolC PC0{proj, Y, bt, sinks[hc0] * LOG2E, (q >> 4) * 4 + (x >> 1), hc0, j, ssqy};
        att::softmax_unit(P, Pn, i + 1 < 12, PC0, i + 1 == 12, true, qn, shm, tkey, F.wave);
    }
#pragma nounroll
    for (int i = 0; i < 4; ++i) {
        const int hc = 2 * (x & 1) + ((q >> 3) & 1);
        att::PolC P{proj, Y, bt, sinks[hc] * LOG2E, i * 8 + (q >> 4) * 4 + (x >> 1), hc, j, ssqy};
        att::PolC Pn{proj, Y, bt, sinks[hc] * LOG2E, ((i + 1) & 3) * 8 + (q >> 4) * 4 + (x >> 1), hc, j, ssqy};
        att::PolSBNext PB0{proj, x, gidx, j};
        att::softmax_unit(P, Pn, i + 1 < 4, PB0, i + 1 == 4, true, qn, shm, tkey, F.wave);
    }
#pragma nounroll
    for (int i = 0; i < 4; ++i) {
        att::sb_unit(proj, Y, ssqy, i * 8 + x, gidx, j, ((i + 1) & 3) * 8 + x, j, i + 1 < 4, true, qn, shm, F.wave);
    }
    }
}
constexpr int PH_P0 = 0, PH_GKV = 1, PH_L0 = 2, PH_PER_LAYER = 10, PH_FN = PH_L0 + DEPTH * PH_PER_LAYER, NPHASE = PH_FN + 1;
#ifndef MK_SPLIT
#define MK_SPLIT 0
#endif
#define IN(k) (lo <= (k) && (k) < hi)
#define SEAM(k) do { if (IN(k) && IN((k) + 1)) xcd_barrier(bar); } while (0)
template <int l> __device__ __forceinline__ void layer_phases(Frame& F, const XcdBarrier& bar, const int lo, const int hi) {
    unsigned char* ws = F.ws;
        const int pb = PH_L0 + l * PH_PER_LAYER;
        const unsigned char* wl = ws + WS_W + (size_t)l * W_LAYER;
        float* ssqA = (float*)(ws + WS_SSQ); float* ssqB = ssqA + (size_t)M * 16; float* ssqC = ssqB + (size_t)M * 16;
        if (IN(pb + 0)) {
            pg8::Gemm g{(const bf16*)(ws + WS_XB), (const bf16*)(wl + WO_IN), M, INW, D}; pg8::StaticOrder S; S.init(M, INW, F.G, (int)blockIdx.x);
            pg8::EpiRowScale<0, true> E{(bf16*)(ws + WS_PROJ), INW, ssqA, (float*)(ws + WS_KMEAN)};
            pg8::gemm_phase<pg8::EpiRowScale<0, true>, pg8::StaticOrder, true, true>(F.lds + RING_OFF, g, S, E, F.wave);
        }
        SEAM(pb + 0);
        if (IN(pb + 2)) {
at_phase(F, l);
 }
        SEAM(pb + 2);
        if (IN(pb + 3)) { nm_merge(F); }
        SEAM(pb + 3);
        if (IN(pb + 4)) {
            pg8::Gemm g{(const bf16*)(ws + WS_Y), (const bf16*)(wl + WO_OUT), M, D, D, (const float*)(ws + WS_RAT)}; pg8::StaticOrder S; S.init(M, D, F.G, (int)blockIdx.x);
            pg8::EpiResid<true> E{(bf16*)(ws + WS_XB), ssqB};
            pg8::gemm_phase<pg8::EpiResid<true>, pg8::StaticOrder, true, true, true>(F.lds + RING_OFF, g, S, E, F.wave);
        }
        SEAM(pb + 4);
        if (IN(pb + 5)) {
            {
                pg8::StaticOrder S3; S3.init(M, XW, F.G, (int)blockIdx.x);
                pg8::Gemm g{(const bf16*)(ws + WS_XB), (const bf16*)(wl + WO_XQ), M, XW, D};
                pg8::EpiRowScale<0> E{(bf16*)(ws + WS_Q2), XW, ssqB, nullptr};
                pg8::gemm_phase<pg8::EpiRowScale<0>, pg8::StaticOrder, true, true>(F.lds + RING_OFF, g, S3, E, F.wave);
            }
            asm volatile("s_waitcnt vmcnt(0)" ::: "memory"); __syncthreads();
            if (F.G == 256) {
                pg8::StaticOrder S3; S3.init(M, XW, F.G, (int)blockIdx.x); pg8::Unit u0; S3.next(0, u0);
                char* shm = F.ldsg + RING_OFF; int tkey = -1; pg8::bf16x8 qn[4];
#pragma nounroll
                for (int hh = 0; hh < 4; ++hh) {
                    att::PolX P{(const bf16*)(ws + WS_Q2), (bf16*)(ws + WS_O2), (const bf16*)(ws + WS_KV), l, u0.pm >> 3, hh, u0.pm & 7};
                    att::PolX Pn{(const bf16*)(ws + WS_Q2), (bf16*)(ws + WS_O2), (const bf16*)(ws + WS_KV), l, u0.pm >> 3, (hh + 1) & 3, u0.pm & 7};
                    att::softmax_unit(P, Pn, hh + 1 < 4, att::PolNone{}, false, hh > 0, qn, shm, tkey, F.wave);
                }
            }
            asm volatile("s_waitcnt vmcnt(0)" ::: "memory"); __syncthreads();
            if (F.G == 256) {
                pg8::StaticOrder S3; S3.init(M, XW, F.G, (int)blockIdx.x); pg8::Unit u0; S3.next(0, u0);
                pg8::Gemm g{(const bf16*)(ws + WS_O2), (const bf16*)(wl + WO_XO), M, D, XW}; int n4 = 4; asm volatile("" : "+s"(n4));     pg8::PanelOrder S4{u0.pm, n4};
                pg8::EpiResid<false> E{(bf16*)(ws + WS_XB), ssqC};
                pg8::gemm_phase<pg8::EpiResid<false>, pg8::PanelOrder, true, true>(F.lds + RING_OFF, g, S4, E, F.wave);
            }
        }
        SEAM(pb + 5);
        if (IN(pb + 8)) {
            pg8::Gemm g{(const bf16*)(ws + WS_XB), (const bf16*)(wl + WO_UP), M, FF, D}; pg8::StaticOrder S; S.init(M, FF, F.G, (int)blockIdx.x);
            pg8::EpiRowScale<1, true> E{(bf16*)(ws + WS_H), FF, ssqC, nullptr};
            pg8::gemm_phase<pg8::EpiRowScale<1, true>, pg8::StaticOrder, true, true>(F.lds + RING_OFF, g, S, E, F.wave);
        }
        SEAM(pb + 8);
        if (IN(pb + 9)) {
            pg8::Gemm g{(const bf16*)(ws + WS_H), (const bf16*)(wl + WO_DOWN), M, D, FF}; pg8::StaticOrder S; S.init(M, D, F.G, (int)blockIdx.x);
            pg8::EpiResid<true> E{(bf16*)(ws + WS_XB), ssqA};
            pg8::gemm_phase<pg8::EpiResid<true>, pg8::StaticOrder, true, true>(F.lds + RING_OFF, g, S, E, F.wave);
        }
        SEAM(pb + 9);
}
#undef IN
#undef SEAM
struct Args { const float* in[17]; float* out; unsigned char* ws; int ph_lo, ph_hi; };
__global__ void __launch_bounds__(NWAVES * 64, 2) mk_fwd(Args args) {
    extern __shared__ __attribute__((aligned(16))) unsigned char lds[];
    Frame F;
    F.lds = (LAS unsigned char*)lds; F.ldsg = (char*)lds;
    F.MISC = (volatile LAS unsigned*)(F.lds + MISC_OFF);
    F.wave = __builtin_amdgcn_readfirstlane((int)threadIdx.x >> 6);
    F.G = gridDim.x;
    unsigned char* ws = args.ws; F.ws = ws; F.out = args.out;
    F.ctl = (gu32*)(ws + WS_CTL);
    F.in = args.in;
    for (int u = FTID; u < (LDS_BYTES - LDSCTL_OFF) / 4; u += NWAVES * 64) ((LAS unsigned*)(F.lds + LDSCTL_OFF))[u] = 0u;
    __syncthreads();
    XcdBarrier bar; bar.wave = F.wave; bar.bar = (unsigned*)(F.ctl + CW_BAR); bar.x = 0; bar.st = nullptr;
    if (!MK_SPLIT) bar = xcd_barrier_post((unsigned*)(F.ctl + CW_BAR), F.MISC + 8, F.wave);
    const int lo = args.ph_lo, hi = args.ph_hi;
#define IN(k) (lo <= (k) && (k) < hi)
#define SEAM(k) do { if (IN(k) && IN((k) + 1)) xcd_barrier(bar); } while (0)

    if (IN(PH_P0)) { p0_prologue(F); }
    SEAM(PH_P0);
    if (IN(PH_GKV)) {
        pg8::Gemm g{(const bf16*)(ws + WS_MEMN), (const bf16*)(ws + WS_WXKV), MROWS, 1024, D}; pg8::StaticOrder S; S.init(MROWS, 1024, F.G, (int)blockIdx.x);
        pg8::EpiRowScale<0, true> E{(bf16*)(ws + WS_KV), 1024, nullptr, nullptr};
        pg8::gemm_phase<pg8::EpiRowScale<0, true>, pg8::StaticOrder, true, true>(F.lds + RING_OFF, g, S, E, F.wave);
    }
    layer_phases<0>(F, bar, lo, hi);
    layer_phases<1>(F, bar, lo, hi);
    if (IN(PH_FN)) { fn_finalnorm(F, (const float*)(ws + WS_SSQ)); }
#undef IN
#undef SEAM
}

extern "C" void kernel_launch(void* const* d_in, const int* in_sizes, int n_in, void* d_out, int out_size, void* d_ws, size_t ws_size, hipStream_t stream) {
    static int grid = 0;
    if (grid == 0) {
        if (n_in != 17 || in_sizes[0] != M * D || out_size != M * D || ws_size < WS_END) { fprintf(stderr, "kernel_launch: unexpected shapes (n_in %d, in0 %d, out %d, ws %zu); nothing launched\n", n_in, n_in > 0 ? in_sizes[0] : -1, out_size, ws_size); grid = -1; return; }
        int dev = 0, cus = 0, per_cu = 0;
        if (hipGetDevice(&dev) != hipSuccess || hipDeviceGetAttribute(&cus, hipDeviceAttributeMultiprocessorCount, dev) != hipSuccess) { grid = -1; return; }
        if (hipFuncSetAttribute((const void*)mk_fwd, hipFuncAttributeMaxDynamicSharedMemorySize, LDS_BYTES) != hipSuccess) { grid = -1; return; }
        if (hipOccupancyMaxActiveBlocksPerMultiprocessor(&per_cu, (const void*)mk_fwd, NWAVES * 64, LDS_BYTES) != hipSuccess || per_cu < 1) { fprintf(stderr, "kernel_launch: occupancy query says %d\n", per_cu); }
        (void)hipGetLastError();
        grid = cus;
    }
    if (grid < 0) return;
    if (hipMemsetAsync((char*)d_ws + WS_CTL, 0, CTL_ZERO_BYTES, stream) != hipSuccess) return;
    Args a{};
    for (int i = 0; i < 17; ++i) a.in[i] = (const float*)d_in[i];
    a.out = (float*)d_out; a.ws = (unsigned char*)d_ws;
#if MK_SPLIT
    for (int p = 0; p < NPHASE; ++p) { a.ph_lo = p; a.ph_hi = p + 1; hipLaunchKernelGGL(mk_fwd, dim3(grid), dim3(NWAVES * 64), LDS_BYTES, stream, a); }
#else
    a.ph_lo = 0; a.ph_hi = NPHASE; hipLaunchKernelGGL(mk_fwd, dim3(grid), dim3(NWAVES * 64), LDS_BYTES, stream, a);
#endif
}
```
